# Optimizing an MI355X kernel written in HIP

```python
import math
import jax, jax.numpy as jnp
from jax import lax
import numpy as np

D_MODEL = 1024
BATCH = 8
SEQ = 8192
DEPTH = 1
DEC_BATCH = 128
DEC_SEQ = 1
PAST_LEN = 8192
PAGE_SIZE = 128

EPS = 1e-6
D_FF = ((8 * D_MODEL // 3 + 127) // 128) * 128
D_PLE = 256
D_INNER = 2 * D_MODEL
SSM_HEAD_DIM = 64
SSM_HEADS = D_INNER // SSM_HEAD_DIM
SSM_GROUPS = 4
SSM_HPG = SSM_HEADS // SSM_GROUPS
SSM_STATE = 128
CONV_W = 4
CONV_DIM = D_INNER + 2 * SSM_GROUPS * SSM_STATE
SSD_CHUNK = 128
DIL_GROUPS = ((128, 1), (512, 4), (2048, 16))
N_DIL = len(DIL_GROUPS)
HPG = 8
ATTN_HEAD_DIM = 64
ATTN_HEADS = N_DIL * HPG
ATTN_WIDTH = ATTN_HEADS * ATTN_HEAD_DIM
ATTN_OUT = HPG * ATTN_HEAD_DIM
ATTN_SCALE = ATTN_HEAD_DIM ** -0.5
ROPE_THETA = 10000.0
IN_SPLITS = tuple(int(c) for c in np.cumsum([D_INNER, CONV_DIM, SSM_HEADS, ATTN_WIDTH, ATTN_WIDTH, ATTN_WIDTH, D_MODEL]))
N_IN = IN_SPLITS[-1] + D_MODEL

kernel_name = 'hybrid_ssd_dilated_attn_decode_step'


def rms_norm(x, gain):
    xf = x.astype(jnp.float32)
    y = xf * lax.rsqrt(jnp.mean(xf * xf, axis=-1, keepdims=True) + EPS)
    return (y * gain.astype(jnp.float32)).astype(x.dtype)


def swiglu(u, w_gate, w_up, w_down):
    return (jax.nn.silu(u @ w_gate) * (u @ w_up)) @ w_down


def rotary(x, pos):
    half = x.shape[-1] // 2
    inv_freq = ROPE_THETA ** (-jnp.arange(half, dtype=jnp.float32) / half)
    ang = pos.astype(jnp.float32)[:, None] * inv_freq[None, :]
    cos = jnp.cos(ang)[None, :, None, :]
    sin = jnp.sin(ang)[None, :, None, :]
    xf = x.astype(jnp.float32)
    x1, x2 = xf[..., :half], xf[..., half:]
    return jnp.concatenate([x1 * cos - x2 * sin, x2 * cos + x1 * sin], axis=-1).astype(x.dtype)


def causal_conv(xbc, prev, w, b):
    s = xbc.shape[1]
    xp = jnp.concatenate([prev.astype(xbc.dtype), xbc], axis=1)
    out = b
    for tap in range(CONV_W):
        out = out + xp[:, tap:tap + s] * w[tap]
    return jax.nn.silu(out), xp[:, xp.shape[1] - (CONV_W - 1):]


def ssd_chunked(x, dt, a, bm, cm):
    b, s, g, hg, p = x.shape
    n = bm.shape[-1]
    L = SSD_CHUNK
    nc = s // L

    def chunks(t):
        return jnp.moveaxis(t.reshape((b, nc, L) + t.shape[2:]), 1, 0)

    causal = jnp.tril(jnp.ones((L, L), dtype=bool))[None, :, :, None, None]

    def step(state, inp):
        xc, dtc, bc, cc = inp
        acs = jnp.cumsum(dtc * a, axis=1)
        seg = acs[:, :, None] - acs[:, None, :]
        decay = jnp.exp(jnp.where(causal, seg, -jnp.inf))
        cb = jnp.einsum('blgn,bsgn->blsg', cc, bc)
        wts = cb[..., None] * decay * dtc[:, None]
        y = jnp.einsum('blsgh,bsghp->blghp', wts, xc)
        y = y + jnp.einsum('blgn,bghpn->blghp', cc, state) * jnp.exp(acs)[..., None]
        to_end = jnp.exp(acs[:, -1:] - acs) * dtc
        state = jnp.exp(acs[:, -1])[..., None, None] * state + jnp.einsum('bsgh,bsgn,bsghp->bghpn', to_end, bc, xc)
        return state, y

    init = jnp.zeros((b, g, hg, p, n), jnp.float32)
    final, ys = lax.scan(step, init, (chunks(x), chunks(dt), chunks(bm), chunks(cm)))
    return jnp.moveaxis(ys, 0, 1).reshape(b, s, g, hg, p), final


def ssd_recurrent(x, dt, a, bm, cm, state):
    def step(st, inp):
        xt, dtt, bt, ct = inp
        st = jnp.exp(dtt * a)[..., None, None] * st + jnp.einsum('bgh,bgn,bghp->bghpn', dtt, bt, xt)
        return st, jnp.einsum('bgn,bghpn->bghp', ct, st)

    final, ys = lax.scan(step, state, (jnp.moveaxis(x, 1, 0), jnp.moveaxis(dt, 1, 0), jnp.moveaxis(bm, 1, 0), jnp.moveaxis(cm, 1, 0)))
    return jnp.moveaxis(ys, 0, 1), final


def ssd_branch(z, xbc, dt_raw, conv_prev, ssm_prev, conv_w, conv_b, dt_bias, a_log, d_skip, norm_g):
    b, s, _ = z.shape
    xbc, conv_new = causal_conv(xbc, conv_prev, conv_w, conv_b)
    xs, bm, cm = jnp.split(xbc, [D_INNER, D_INNER + SSM_GROUPS * SSM_STATE], axis=-1)
    xs = xs.reshape(b, s, SSM_GROUPS, SSM_HPG, SSM_HEAD_DIM).astype(jnp.float32)
    bm = bm.reshape(b, s, SSM_GROUPS, SSM_STATE).astype(jnp.float32)
    cm = cm.reshape(b, s, SSM_GROUPS, SSM_STATE).astype(jnp.float32)
    dt = jax.nn.softplus(dt_raw.astype(jnp.float32) + dt_bias.astype(jnp.float32)).reshape(b, s, SSM_GROUPS, SSM_HPG)
    a = -jnp.exp(a_log.astype(jnp.float32)).reshape(SSM_GROUPS, SSM_HPG)
    if ssm_prev is None:
        y, st = ssd_chunked(xs, dt, a, bm, cm)
    else:
        st0 = ssm_prev.astype(jnp.float32).reshape(b, SSM_GROUPS, SSM_HPG, SSM_HEAD_DIM, SSM_STATE)
        y, st = ssd_recurrent(xs, dt, a, bm, cm, st0)
    y = y + d_skip.astype(jnp.float32).reshape(SSM_GROUPS, SSM_HPG)[:, :, None] * xs
    y = y.reshape(b, s, D_INNER).astype(z.dtype)
    y = rms_norm(y * jax.nn.silu(z), norm_g)
    return y, conv_new, st.reshape(b, SSM_HEADS, SSM_HEAD_DIM, SSM_STATE)


def dilated_attention_prompt(q, k, v, window, dil):
    b, s, h, dh = q.shape
    nk = window // dil
    sp = -(-s // window) * window
    nb = sp // window

    def to_blocks(t):
        t = jnp.pad(t.astype(jnp.float32), ((0, 0), (0, sp - s), (0, 0), (0, 0)))
        t = t.reshape(b, sp // dil, dil, h, dh).transpose(0, 2, 1, 3, 4)
        return t.reshape(b, dil, nb, nk, h, dh)

    qb, kb, vb = to_blocks(q), to_blocks(k), to_blocks(v)

    def with_prev(t):
        prev = jnp.pad(t, ((0, 0), (0, 0), (1, 0), (0, 0), (0, 0), (0, 0)))[:, :, :-1]
        return jnp.concatenate([prev, t], axis=3)

    kk, vv = with_prev(kb), with_prev(vb)
    scores = jnp.einsum('brnihd,brnjhd->brnhij', qb, kk) * ATTN_SCALE
    qi = jnp.arange(nk)[:, None]
    kj = jnp.arange(2 * nk)[None, :]
    dist = qi + nk - kj
    band = (dist >= 0) & (dist <= nk)
    has_prev = (jnp.arange(nb) > 0)[:, None, None] | (kj >= nk)[None]
    mask = band[None] & has_prev
    scores = jnp.where(mask[None, None, :, None], scores, -jnp.inf)
    m = jnp.max(scores, axis=-1, keepdims=True)
    p = jnp.exp(scores - m)
    l = jnp.sum(p, axis=-1, keepdims=True)
    o = jnp.einsum('brnhij,brnjhd->brnihd', p / l, vv)
    lse = (m + jnp.log(l))[..., 0]
    o = o.reshape(b, dil, sp // dil, h, dh).transpose(0, 2, 1, 3, 4).reshape(b, sp, h, dh)[:, :s]
    lse = lse.transpose(0, 1, 2, 4, 3).reshape(b, dil, sp // dil, h).transpose(0, 2, 1, 3).reshape(b, sp, h)[:, :s]
    return o, lse


def dilated_attention_sample(q, k, v, cache_kv, window, dil):
    lc = cache_kv.shape[1]
    t = q.shape[1]
    nk = window // dil
    keys = jnp.concatenate([cache_kv[:, :, 0].astype(jnp.float32), k.astype(jnp.float32)], axis=1)
    vals = jnp.concatenate([cache_kv[:, :, 1].astype(jnp.float32), v.astype(jnp.float32)], axis=1)
    idx = lc + jnp.arange(t)[:, None] - dil * jnp.arange(nk + 1)[None, :]
    valid = idx >= 0
    idx = jnp.maximum(idx, 0)
    kg = keys[:, idx]
    vg = vals[:, idx]
    scores = jnp.einsum('bthd,btkhd->bthk', q.astype(jnp.float32), kg) * ATTN_SCALE
    scores = jnp.where(valid[None, :, None, :], scores, -jnp.inf)
    m = jnp.max(scores, axis=-1, keepdims=True)
    p = jnp.exp(scores - m)
    l = jnp.sum(p, axis=-1, keepdims=True)
    o = jnp.einsum('bthk,btkhd->bthd', p / l, vg)
    lse = (m + jnp.log(l))[..., 0]
    return o, lse


def decoder_layer(x, p_emb, pos, conv_prev, ssm_prev, kv_prev, prm):
    b, s, _ = x.shape
    h = x + 0.5 * swiglu(rms_norm(x, prm['norm_ffn1']), prm['w_ffn1_gate'], prm['w_ffn1_up'], prm['w_ffn1_down'])
    u = rms_norm(h, prm['norm_mix'])
    z, xbc, dt_raw, q, k, v, gate_ssm, gate_attn = jnp.split(u @ prm['w_in'], IN_SPLITS, axis=-1)
    if conv_prev is None:
        conv_prev = jnp.zeros((b, CONV_W - 1, CONV_DIM), x.dtype)
    y_ssm, conv_new, ssm_new = ssd_branch(z, xbc, dt_raw, conv_prev, ssm_prev, prm['conv_w'], prm['conv_b'],
                                          prm['dt_bias'], prm['a_log'], prm['d_skip'], prm['norm_ssm'])
    q = rotary(q.reshape(b, s, ATTN_HEADS, ATTN_HEAD_DIM), pos)
    k = rotary(k.reshape(b, s, ATTN_HEADS, ATTN_HEAD_DIM), pos)
    v = v.reshape(b, s, ATTN_HEADS, ATTN_HEAD_DIM)
    outs, lses, kv_new = [], [], []
    for gi, (window, dil) in enumerate(DIL_GROUPS):
        sl = slice(gi * HPG, (gi + 1) * HPG)
        qg, kg, vg = q[:, :, sl], k[:, :, sl], v[:, :, sl]
        if kv_prev is None:
            o, lse = dilated_attention_prompt(qg, kg, vg, window, dil)
            keep = min(window, s)
            kv_new.append(jnp.stack([kg[:, s - keep:], vg[:, s - keep:]], axis=2))
        else:
            o, lse = dilated_attention_sample(qg, kg, vg, kv_prev[gi], window, dil)
            kv_new.append(jnp.stack([kg, vg], axis=2))
        outs.append(o)
        lses.append(lse)
    alpha = jax.nn.softmax(jnp.stack(lses), axis=0)
    attn = jnp.einsum('gbsh,gbshd->bshd', alpha, jnp.stack(outs)).reshape(b, s, ATTN_OUT).astype(x.dtype)
    merged = jax.nn.sigmoid(gate_ssm) * (y_ssm @ prm['w_o_ssm']) + jax.nn.sigmoid(gate_attn) * (attn @ prm['w_o_attn'])
    h = h + merged @ prm['w_out']
    h = h + 0.5 * swiglu(rms_norm(h, prm['norm_ffn2']), prm['w_ffn2_gate'], prm['w_ffn2_up'], prm['w_ffn2_down'])
    h = h + jax.nn.sigmoid(rms_norm(h, prm['norm_ple']) @ prm['w_ple_gate']) * (p_emb @ prm['w_ple_proj'])
    return h, kv_new, conv_new, ssm_new


def setup_inputs(seed: int = 0) -> dict:
    key = jax.random.key(seed)
    ks = iter(jax.random.split(key, 48))
    f32 = jnp.float32
    L = DEPTH

    def nrm(shape, scale):
        return jax.random.normal(next(ks), shape, f32) * scale

    def gain(shape):
        return 1.0 + nrm(shape, 0.01)

    dt0 = jnp.exp(jax.random.uniform(next(ks), (L, SSM_HEADS), f32, math.log(1e-3), math.log(1e-1)))
    dt_bias = dt0 + jnp.log(-jnp.expm1(-dt0))
    a_log = jnp.log(jax.random.uniform(next(ks), (L, SSM_HEADS), f32, 1.0, 16.0))
    kv_len = [min(w, PAST_LEN) for (w, _) in DIL_GROUPS]
    return {
        'x_prompt': nrm((BATCH, SEQ, D_MODEL), 1.0),
        'x_sample': nrm((DEC_BATCH, DEC_SEQ, D_MODEL), 1.0),
        'cache_kv_w128': nrm((L, DEC_BATCH, kv_len[0], 2, HPG, ATTN_HEAD_DIM), 1.0),
        'cache_kv_w512': nrm((L, DEC_BATCH, kv_len[1], 2, HPG, ATTN_HEAD_DIM), 1.0),
        'cache_kv_w2048': nrm((L, DEC_BATCH, kv_len[2], 2, HPG, ATTN_HEAD_DIM), 1.0),
        'state_conv': nrm((L, DEC_BATCH, CONV_W - 1, CONV_DIM), 1.0),
        'state_ssm': nrm((L, DEC_BATCH, SSM_HEADS, SSM_HEAD_DIM, SSM_STATE), 0.1),
        'p_prompt': nrm((L, BATCH, SEQ, D_PLE), 1.0),
        'p_sample': nrm((L, DEC_BATCH, DEC_SEQ, D_PLE), 1.0),
        'norm_ffn1': gain((L, D_MODEL)),
        'w_ffn1_gate': nrm((L, D_MODEL, D_FF), D_MODEL ** -0.5),
        'w_ffn1_up': nrm((L, D_MODEL, D_FF), D_MODEL ** -0.5),
        'w_ffn1_down': nrm((L, D_FF, D_MODEL), D_FF ** -0.5),
        'norm_mix': gain((L, D_MODEL)),
        'w_in': nrm((L, D_MODEL, N_IN), D_MODEL ** -0.5),
        'conv_w': nrm((L, CONV_W, CONV_DIM), CONV_W ** -0.5),
        'conv_b': nrm((L, CONV_DIM), 0.01),
        'dt_bias': dt_bias,
        'a_log': a_log,
        'd_skip': gain((L, SSM_HEADS)),
        'norm_ssm': gain((L, D_INNER)),
        'w_o_ssm': nrm((L, D_INNER, D_MODEL), D_INNER ** -0.5),
        'w_o_attn': nrm((L, ATTN_OUT, D_MODEL), ATTN_OUT ** -0.5),
        'w_out': nrm((L, D_MODEL, D_MODEL), D_MODEL ** -0.5),
        'norm_ffn2': gain((L, D_MODEL)),
        'w_ffn2_gate': nrm((L, D_MODEL, D_FF), D_MODEL ** -0.5),
        'w_ffn2_up': nrm((L, D_MODEL, D_FF), D_MODEL ** -0.5),
        'w_ffn2_down': nrm((L, D_FF, D_MODEL), D_FF ** -0.5),
        'norm_ple': gain((L, D_MODEL)),
        'w_ple_gate': nrm((L, D_MODEL, D_MODEL), D_MODEL ** -0.5),
        'w_ple_proj': nrm((L, D_PLE, D_MODEL), D_PLE ** -0.5),
        'norm_final': gain((D_MODEL,)),
    }


def reference(x_prompt, x_sample, cache_kv_w128, cache_kv_w512, cache_kv_w2048, state_conv, state_ssm,
              p_prompt, p_sample, norm_ffn1, w_ffn1_gate, w_ffn1_up, w_ffn1_down, norm_mix, w_in,
              conv_w, conv_b, dt_bias, a_log, d_skip, norm_ssm, w_o_ssm, w_o_attn, w_out,
              norm_ffn2, w_ffn2_gate, w_ffn2_up, w_ffn2_down, norm_ple, w_ple_gate, w_ple_proj, norm_final):
    pos_prompt = jnp.arange(x_prompt.shape[1], dtype=jnp.int32)
    pos_sample = PAST_LEN + jnp.arange(x_sample.shape[1], dtype=jnp.int32)
    hp, hs = x_prompt, x_sample
    kvp_l, convp_l, ssmp_l, kvs_l, convs_l, ssms_l = [], [], [], [], [], []
    for i in range(DEPTH):
        prm = {
            'norm_ffn1': norm_ffn1[i], 'w_ffn1_gate': w_ffn1_gate[i], 'w_ffn1_up': w_ffn1_up[i],
            'w_ffn1_down': w_ffn1_down[i], 'norm_mix': norm_mix[i], 'w_in': w_in[i],
            'conv_w': conv_w[i], 'conv_b': conv_b[i], 'dt_bias': dt_bias[i], 'a_log': a_log[i],
            'd_skip': d_skip[i], 'norm_ssm': norm_ssm[i], 'w_o_ssm': w_o_ssm[i], 'w_o_attn': w_o_attn[i],
            'w_out': w_out[i], 'norm_ffn2': norm_ffn2[i], 'w_ffn2_gate': w_ffn2_gate[i],
            'w_ffn2_up': w_ffn2_up[i], 'w_ffn2_down': w_ffn2_down[i], 'norm_ple': norm_ple[i],
            'w_ple_gate': w_ple_gate[i], 'w_ple_proj': w_ple_proj[i],
        }
        hp, kvp, convp, ssmp = decoder_layer(hp, p_prompt[i], pos_prompt, None, None, None, prm)
        hs, kvs, convs, ssms = decoder_layer(hs, p_sample[i], pos_sample, state_conv[i], state_ssm[i],
                                             (cache_kv_w128[i], cache_kv_w512[i], cache_kv_w2048[i]), prm)
        kvp_l.append(kvp); convp_l.append(convp); ssmp_l.append(ssmp)
        kvs_l.append(kvs); convs_l.append(convs); ssms_l.append(ssms)
    y_prompt = rms_norm(hp, norm_final)
    y_sample = rms_norm(hs, norm_final)
    kv128_p = jnp.stack([kv[0] for kv in kvp_l])
    kv512_p = jnp.stack([kv[1] for kv in kvp_l])
    kv2048_p = jnp.stack([kv[2] for kv in kvp_l])
    kv128_s = jnp.stack([kv[0] for kv in kvs_l])
    kv512_s = jnp.stack([kv[1] for kv in kvs_l])
    kv2048_s = jnp.stack([kv[2] for kv in kvs_l])
    conv_p = jnp.stack(convp_l)
    ssm_p = jnp.stack(ssmp_l)
    conv_s = jnp.stack(convs_l)
    ssm_s = jnp.stack(ssms_l)
    return (y_prompt, y_sample, kv128_p, kv512_p, kv2048_p, conv_p, ssm_p, kv128_s, kv512_s, kv2048_s, conv_s, ssm_s)
```

```cpp
#include <hip/hip_runtime.h>
#include <cstdio>
#include <cstdint>

constexpr int P_ROWS = 65536, S_ROWS = 128, M_REAL = P_ROWS + S_ROWS, M_PAD = 257 * 256, SEQ_T = 8192;
constexpr int NWAVES = 8;
constexpr int DM = 1024, DFF = 2816, DPLE = 256, DINNER = 2048, CONVD = 3072, NHEAD_S = 32, NSTATE = 128, AW = 1536, NV_IN = 47 * 256;
constexpr float EPS = 1e-6f;

constexpr size_t MiB = 1u << 20;
constexpr size_t rup(size_t x) { return (x + MiB - 1) / MiB * MiB; }
constexpr size_t WS_CTL = 0, CTL_ZERO_BYTES = 1 * MiB;
constexpr size_t WS_W1A = 1 * MiB;
constexpr size_t WS_W2A = WS_W1A + rup((size_t)5632 * 1024 * 2);
constexpr size_t WS_WIN = WS_W2A + rup((size_t)1024 * 2816 * 2);
constexpr size_t WS_WOS = WS_WIN + rup((size_t)NV_IN * 1024 * 2);
constexpr size_t WS_WOA = WS_WOS + rup((size_t)1024 * 2048 * 2);
constexpr size_t WS_WOUT = WS_WOA + rup((size_t)1024 * 512 * 2);
constexpr size_t WS_W1B = WS_WOUT + rup((size_t)1024 * 1024 * 2);
constexpr size_t WS_W2B = WS_W1B + rup((size_t)5632 * 1024 * 2);
constexpr size_t WS_WPG = WS_W2B + rup((size_t)1024 * 2816 * 2);
constexpr size_t WS_WPP = WS_WPG + rup((size_t)1024 * 1024 * 2);
constexpr size_t WS_CS = WS_WPP + rup((size_t)1024 * 256 * 2);
constexpr size_t WS_U = WS_CS + rup((size_t)8193 * 32 * 8);
constexpr size_t WS_H1 = WS_U + rup((size_t)M_PAD * 1024 * 2);
constexpr size_t WS_HR = WS_H1 + rup((size_t)M_PAD * 2816 * 2);
constexpr size_t WS_PB = WS_HR + rup((size_t)M_PAD * 1024 * 4);
constexpr size_t WS_PP = WS_PB + rup((size_t)M_PAD * 256 * 2);
constexpr size_t WS_Z = WS_PP + rup((size_t)M_PAD * 1024 * 2);
constexpr size_t WS_XBC = WS_Z + rup((size_t)M_PAD * 2048 * 2);
constexpr size_t WS_Q = WS_XBC + rup((size_t)M_PAD * 3072 * 2);
constexpr size_t WS_K = WS_Q + rup((size_t)M_PAD * 1536 * 2);
constexpr size_t WS_V = WS_K + rup((size_t)M_PAD * 1536 * 2);
constexpr size_t WS_GS = WS_V + rup((size_t)M_PAD * 1536 * 2);
constexpr size_t WS_GA = WS_GS + rup((size_t)M_PAD * 1024 * 2);
constexpr size_t WS_DT = WS_GA + rup((size_t)M_PAD * 1024 * 2);
constexpr size_t WS_YG = WS_DT + rup((size_t)M_PAD * 32 * 4);
constexpr size_t WS_SSQ = WS_YG + rup((size_t)M_PAD * 2048 * 2);
constexpr size_t WS_RSTD = WS_SSQ + rup((size_t)M_PAD * 64 * 4);
constexpr size_t WS_AOG = WS_RSTD + rup((size_t)M_PAD * 4);
constexpr size_t AOG_STRIDE = (size_t)M_PAD * 512;
constexpr size_t WS_LSE = WS_AOG + rup(3 * AOG_STRIDE * 2);
constexpr size_t LSE_STRIDE = (size_t)M_PAD * 8;
constexpr size_t WS_AO = WS_LSE + rup(3 * LSE_STRIDE * 4);
constexpr size_t WS_T1 = WS_AO + rup((size_t)M_PAD * 512 * 2);
constexpr size_t WS_MG = WS_T1 + rup((size_t)M_PAD * 1024 * 4);
constexpr size_t WS_QS = WS_MG + rup((size_t)M_PAD * 1024 * 2);
constexpr size_t WS_XC = WS_QS + rup((size_t)128 * 24 * 64 * 4);
constexpr size_t WS_SQ2 = WS_XC + rup((size_t)65536 * 3072 * 2);
constexpr size_t WS_T1S = WS_SQ2 + rup((size_t)3 * M_PAD * 4);
constexpr size_t WS_END = WS_T1S + rup((size_t)256 * 1024 * 4);
constexpr int CW_TMO = 0, CW_CODE = 1, CW_NRM = 64, CW_BAR = 4096;

namespace pg8 {
#define PG8_LAS __attribute__((address_space(3)))
typedef unsigned short bf16_t;
typedef short bf16x8 __attribute__((ext_vector_type(8)));
typedef float f32x4 __attribute__((ext_vector_type(4)));
typedef unsigned u32x4 __attribute__((ext_vector_type(4)));
constexpr int BM = 256, BK = 64, HALF = 128, HTB = HALF * BK * 2  , STAGE_BYTES = 8 * HTB, NXCD = 8, WGM = 8;

__host__ __device__ __forceinline__ int lds_byte(int r, int c) { const int st = (r >> 4) * 2 + (c >> 5), rr = r & 15, cc = c & 31, ob = rr * 64 + cc * 2; return st * 1024 + (ob ^ (((ob >> 9) & 1) << 5)); }
__host__ __device__ __forceinline__ void stage_rc(int b, int& R, int& C) { const int st = b / 1024, sb = b % 1024, swz = sb ^ (((sb >> 9) & 1) << 5); R = (st >> 1) * 16 + swz / 64; C = (st & 1) * 32 + (swz % 64) / 2; }
__host__ __device__ __forceinline__ int perm32(int rho) { const int n = rho >> 4, i = rho & 15; return 8 * (i >> 2) + 4 * n + (i & 3); }

struct Unit { int pm, pn, ko; };
struct Gemm { const bf16_t* A; const bf16_t* Bt; int M, N, K, ld; };

struct StaticOrder {
    int nM, nN, nwg, G, c, rev;
    __host__ __device__ void init(int M, int N, int G_, int c_, int rev_ = 0) { nM = M / BM; nN = N / BM; nwg = nM * nN; G = G_; c = c_; rev = rev_; }
    __host__ __device__ bool next(int i, Unit& u) const {
        const long L = (long)i * G + c; if (L >= nwg) return false;
        int wgid = (int)L; { const int q = nwg / NXCD, r = nwg % NXCD, xcd = wgid % NXCD, off = wgid / NXCD; wgid = (xcd < r ? xcd * (q + 1) : r * (q + 1) + (xcd - r) * q) + off; }
        const int nig = WGM * nN, gid = wgid / nig, fm = gid * WGM, gsz = (nM - fm) < WGM ? (nM - fm) : WGM;
        const int pm = fm + ((wgid % nig) % gsz); u.pm = rev ? nM - 1 - pm : pm; u.pn = (wgid % nig) / gsz; u.ko = 0; return true;
    }
    __device__ __forceinline__ void a_ready(const Unit&) const {}
    __device__ __forceinline__ void done(const Unit&) const {}
};

struct SampOrder {
    int nN, P, Kp, G, c;
    __device__ __forceinline__ void init(int N, int P_, int Kp_, int G_, int c_) { nN = N / BM; P = P_; Kp = Kp_; G = G_; c = c_; }
    __device__ __forceinline__ bool next(int i, Unit& u) const { const long L = (long)i * G + c; if (L >= (long)nN * P) return false;
        int pm = 256; asm volatile("" : "+s"(pm));
        u.pm = pm; u.pn = (int)(L % nN); u.ko = (int)(L / nN) * Kp; return true; }
    __device__ __forceinline__ void a_ready(const Unit&) const {}
    __device__ __forceinline__ void done(const Unit&) const {}
};

struct RangeOrder {
    int L0, L1, G, c;
    __device__ __forceinline__ void init(int L0_, int L1_, int G_, int c_) { L0 = L0_; L1 = L1_; G = G_; c = c_; }
    __device__ __forceinline__ bool next(int i, Unit& u) const { const int L = L0 + i * G + c; if (L >= L1) return false; u.pm = L >> 2; u.pn = L & 3; u.ko = 0; return true; }
    __device__ __forceinline__ void a_ready(const Unit&) const {}
    __device__ __forceinline__ void done(const Unit&) const {}
};

__device__ __forceinline__ unsigned cvt_pk_bf16(float lo, float hi) { unsigned r; asm volatile("v_cvt_pk_bf16_f32 %0, %1, %2" : "=v"(r) : "v"(lo), "v"(hi)); return r; }

constexpr float C2Q = 0.125f * 1.4426950408889634f;
typedef float f32x2e __attribute__((ext_vector_type(2)));
typedef unsigned u32x2e __attribute__((ext_vector_type(2)));

__device__ __forceinline__ float ex2(float x) { return __builtin_amdgcn_exp2f(x); }
__device__ __forceinline__ float sigm(float x) { return __builtin_amdgcn_rcpf(1.0f + ex2(-1.4426950408889634f * x)); }
__device__ __forceinline__ float silu_f(float x) { return x * sigm(x); }
__device__ __forceinline__ float softplus_f(float x) { return x > 20.f ? x : 0.6931471805599453f * __builtin_amdgcn_logf(1.0f + ex2(1.4426950408889634f * x)); }
__device__ __forceinline__ u32x4 pack8(const f32x4 a, const f32x4 b) { u32x4 w; w.x = cvt_pk_bf16(a[0], a[1]); w.y = cvt_pk_bf16(a[2], a[3]); w.z = cvt_pk_bf16(b[0], b[1]); w.w = cvt_pk_bf16(b[2], b[3]); return w; }
__device__ __forceinline__ float bf_lo(unsigned w) { return __builtin_bit_cast(float, w << 16); }
__device__ __forceinline__ float bf_hi(unsigned w) { return __builtin_bit_cast(float, w & 0xffff0000u); }

template <bool RS> struct EpiSwiGLU {
    static constexpr bool PERM = true, AFTER_DRAIN = false;
    bf16_t* O; int ldc; const float* ssq;
    __device__ __forceinline__ void operator()(const f32x4 (&acc)[2][2][4][2], const Unit& u, int wr, int wc, int fr, int fq) const {
        const int row0 = u.pm * BM + wr * 64 + fr, col0 = u.pn * HALF + wc * 32 + 8 * fq;
        float rsv[2][4];
#pragma unroll
        for (int ai = 0; ai < 2; ++ai)
#pragma unroll
            for (int m = 0; m < 4; ++m) rsv[ai][m] = RS ? ssq[row0 + ai * HALF + m * 16] : 0.f;
#pragma unroll
        for (int ai = 0; ai < 2; ++ai)
#pragma unroll
            for (int m = 0; m < 4; ++m) {
                const int row = row0 + ai * HALF + m * 16;
                bf16_t* rowp = O + (size_t)row * ldc + col0;
                const float rs = RS ? __builtin_amdgcn_rsqf(rsv[ai][m] * (1.f / 1024.f) + 1e-6f) : 1.0f;
                f32x4 v0, v1;
#pragma unroll
                for (int j = 0; j < 4; ++j) { v0[j] = silu_f(acc[ai][0][m][0][j] * rs) * (acc[ai][1][m][0][j] * rs); v1[j] = silu_f(acc[ai][0][m][1][j] * rs) * (acc[ai][1][m][1][j] * rs); }
                *(u32x4*)rowp = pack8(v0, v1);
            }
    }
};

template <int MODE, bool NORM> struct EpiResid {
    static constexpr bool PERM = false, AFTER_DRAIN = false;
    const float* R0; const float* R1; float* O; float scale; const bf16_t* PP; const float* ssq_in; bf16_t* HB; float* ssq_out;
    __device__ __forceinline__ void operator()(const f32x4 (&acc)[2][2][4][2], const Unit& u, int wr, int wc, int fr, int fq) const {
        const int col0 = u.pn * BM + wc * 32 + 4 * fq;
        constexpr int MB = MODE == 1 ? 2 : 4;
#pragma unroll
        for (int ab = 0; ab < 8 / MB; ++ab) {
            const int ai = (ab * MB) >> 2, m0 = (ab * MB) & 3;
            f32x4 rv[MB][2][2]; u32x2e pw[MB][2][2]; float rsi[MB];
#pragma unroll
            for (int mm = 0; mm < MB; ++mm) { const int m = mm;
                const int row = u.pm * BM + ai * HALF + wr * 64 + (m0 + mm) * 16 + fr;
                const float* rp = row < P_ROWS ? R0 + (size_t)row * 1024 : R1 + (size_t)(row - P_ROWS) * 1024;
                const bool live = row < M_REAL;
                rsi[m] = MODE == 1 ? ssq_in[row] : 0.f;
#pragma unroll
                for (int bj = 0; bj < 2; ++bj)
#pragma unroll
                    for (int n = 0; n < 2; ++n) { const int c = col0 + bj * HALF + n * 16;
                        rv[m][bj][n] = live ? *(const f32x4*)(rp + c) : (f32x4){0.f, 0.f, 0.f, 0.f};
                        if (MODE == 1) pw[m][bj][n] = *(const u32x2e*)(PP + (size_t)row * 1024 + c); }
            }
#pragma unroll
            for (int mm = 0; mm < MB; ++mm) { const int m = mm;
                const int row = u.pm * BM + ai * HALF + wr * 64 + (m0 + mm) * 16 + fr;
                const float rs1 = MODE == 1 ? __builtin_amdgcn_rsqf(rsi[m] * (1.f / 1024.f) + 1e-6f) : 1.0f;
                float sq = 0.f;
#pragma unroll
                for (int bj = 0; bj < 2; ++bj)
#pragma unroll
                    for (int n = 0; n < 2; ++n) {
                        const int c = col0 + bj * HALF + n * 16;
                        f32x4 r = rv[m][bj][n];
                        const f32x4 a = acc[ai][bj][m0 + mm][n];
                        if (MODE == 0) r = r + a * scale;
                        else { const u32x2e p2 = pw[m][bj][n];
                               r[0] += sigm(a[0] * rs1) * bf_lo(p2.x); r[1] += sigm(a[1] * rs1) * bf_hi(p2.x); r[2] += sigm(a[2] * rs1) * bf_lo(p2.y); r[3] += sigm(a[3] * rs1) * bf_hi(p2.y); }
                        *(f32x4*)(O + (size_t)row * 1024 + c) = r;
                        if (NORM) { u32x2e hw; hw.x = cvt_pk_bf16(r[0], r[1]); hw.y = cvt_pk_bf16(r[2], r[3]); *(u32x2e*)(HB + (size_t)row * 1024 + c) = hw;
                                    sq += (r[0] * r[0] + r[1] * r[1]) + (r[2] * r[2] + r[3] * r[3]); }
                    }
                if (NORM) { sq += __shfl_xor(sq, 16); sq += __shfl_xor(sq, 32);
                            if (fq == 0) __hip_atomic_fetch_add(ssq_out + row, sq, __ATOMIC_RELAXED, __HIP_MEMORY_SCOPE_AGENT); }
            }
        }
    }
};
template <bool SRC_F32, int SCALE2  > struct EpiResBf {
    static constexpr bool PERM = true, AFTER_DRAIN = false;
    const float* R0; bf16_t* HB; float* ssq_out;
    __device__ __forceinline__ void operator()(const f32x4 (&acc)[2][2][4][2], const Unit& u, int wr, int wc, int fr, int fq) const {
        const int row0 = u.pm * BM + wr * 64 + fr, col0 = u.pn * BM + wc * 32 + 8 * fq;
        constexpr float scale = 0.5f * SCALE2;
#pragma unroll
        for (int ai = 0; ai < 2; ++ai) {
            f32x4 rf[4][2][2]; u32x4 rb[4][2];
#pragma unroll
            for (int m = 0; m < 4; ++m)
#pragma unroll
                for (int bj = 0; bj < 2; ++bj) { const size_t o = (size_t)(row0 + ai * HALF + m * 16) * 1024 + col0 + bj * HALF;
                    if constexpr (SRC_F32) { rf[m][bj][0] = *(const f32x4*)(R0 + o); rf[m][bj][1] = *(const f32x4*)(R0 + o + 4); rb[m][bj] = (u32x4){0u, 0u, 0u, 0u}; }
                    else { rb[m][bj] = *(const u32x4*)(HB + o); rf[m][bj][0] = (f32x4){0.f, 0.f, 0.f, 0.f}; rf[m][bj][1] = rf[m][bj][0]; } }
#pragma unroll
            for (int m = 0; m < 4; ++m) {
                const int row = row0 + ai * HALF + m * 16;
                float sq = 0.f;
#pragma unroll
                for (int bj = 0; bj < 2; ++bj) {
                    const size_t o = (size_t)row * 1024 + col0 + bj * HALF;
                    f32x4 r0, r1;
                    if constexpr (SRC_F32) { r0 = rf[m][bj][0]; r1 = rf[m][bj][1]; }
                    else { const u32x4 w = rb[m][bj]; r0 = (f32x4){bf_lo(w.x), bf_hi(w.x), bf_lo(w.y), bf_hi(w.y)}; r1 = (f32x4){bf_lo(w.z), bf_hi(w.z), bf_lo(w.w), bf_hi(w.w)}; }
                    r0 = r0 + acc[ai][bj][m][0] * scale; r1 = r1 + acc[ai][bj][m][1] * scale;
                    *(u32x4*)(HB + o) = pack8(r0, r1);
                    sq += ((r0[0] * r0[0] + r0[1] * r0[1]) + (r0[2] * r0[2] + r0[3] * r0[3])) + ((r1[0] * r1[0] + r1[1] * r1[1]) + (r1[2] * r1[2] + r1[3] * r1[3]));
                }
                sq += __shfl_xor(sq, 16); sq += __shfl_xor(sq, 32);
                if (fq == 0) __hip_atomic_fetch_add(ssq_out + row, sq, __ATOMIC_RELAXED, __HIP_MEMORY_SCOPE_AGENT);
            }
        }
    }
};
struct EpiPle {
    static constexpr bool PERM = true, AFTER_DRAIN = false;
    const bf16_t* HB; const bf16_t* PP; const float* ssq_in; bf16_t* OUT;
    __device__ __forceinline__ void operator()(const f32x4 (&acc)[2][2][4][2], const Unit& u, int wr, int wc, int fr, int fq) const {
        const int row0 = u.pm * BM + wr * 64 + fr, col0 = u.pn * BM + wc * 32 + 8 * fq;
#pragma unroll
        for (int ai = 0; ai < 2; ++ai) {
            u32x4 hv[4][2], pw[4][2]; float rsi[4];
#pragma unroll
            for (int m = 0; m < 4; ++m) { const int row = row0 + ai * HALF + m * 16; rsi[m] = ssq_in[row];
#pragma unroll
                for (int bj = 0; bj < 2; ++bj) { const size_t o = (size_t)row * 1024 + col0 + bj * HALF; hv[m][bj] = *(const u32x4*)(HB + o); pw[m][bj] = *(const u32x4*)(PP + o); } }
#pragma unroll
            for (int m = 0; m < 4; ++m) {
                const int row = row0 + ai * HALF + m * 16;
                const float rs1 = __builtin_amdgcn_rsqf(rsi[m] * (1.f / 1024.f) + 1e-6f);
#pragma unroll
                for (int bj = 0; bj < 2; ++bj) { const f32x4 a0 = acc[ai][bj][m][0], a1 = acc[ai][bj][m][1]; const u32x4 h4 = hv[m][bj], p4 = pw[m][bj];
                    f32x4 r0, r1;
                    r0[0] = bf_lo(h4.x) + sigm(a0[0] * rs1) * bf_lo(p4.x); r0[1] = bf_hi(h4.x) + sigm(a0[1] * rs1) * bf_hi(p4.x); r0[2] = bf_lo(h4.y) + sigm(a0[2] * rs1) * bf_lo(p4.y); r0[3] = bf_hi(h4.y) + sigm(a0[3] * rs1) * bf_hi(p4.y);
                    r1[0] = bf_lo(h4.z) + sigm(a1[0] * rs1) * bf_lo(p4.z); r1[1] = bf_hi(h4.z) + sigm(a1[1] * rs1) * bf_hi(p4.z); r1[2] = bf_lo(h4.w) + sigm(a1[2] * rs1) * bf_lo(p4.w); r1[3] = bf_hi(h4.w) + sigm(a1[3] * rs1) * bf_hi(p4.w);
                    *(u32x4*)(OUT + (size_t)row * 1024 + col0 + bj * HALF) = pack8(r0, r1); }
            }
        }
    }
};
struct EpiResidAt {
    static constexpr bool PERM = false, AFTER_DRAIN = false;
    float* O; float scale;
    __device__ __forceinline__ void operator()(const f32x4 (&acc)[2][2][4][2], const Unit& u, int wr, int wc, int fr, int fq) const {
        const int col0 = u.pn * BM + wc * 32 + 4 * fq;
#pragma unroll
        for (int m = 0; m < 4; ++m) {
            const int row = u.pm * BM + wr * 64 + m * 16 + fr;
#pragma unroll
            for (int bj = 0; bj < 2; ++bj)
#pragma unroll
                for (int n = 0; n < 2; ++n) { float* p = O + (size_t)row * 1024 + col0 + bj * HALF + n * 16; const f32x4 a = acc[0][bj][m][n];
#pragma unroll
                    for (int j = 0; j < 4; ++j) __hip_atomic_fetch_add(p + j, a[j] * scale, __ATOMIC_RELAXED, __HIP_MEMORY_SCOPE_AGENT); }
        }
    }
};

struct EpiStoreBf16 {
    static constexpr bool PERM = true, AFTER_DRAIN = false;
    bf16_t* O; int ldc;
    __device__ __forceinline__ void operator()(const f32x4 (&acc)[2][2][4][2], const Unit& u, int wr, int wc, int fr, int fq) const {
        const int row0 = u.pm * BM + wr * 64 + fr, col0 = u.pn * BM + wc * 32 + 8 * fq;
#pragma unroll
        for (int ai = 0; ai < 2; ++ai)
#pragma unroll
            for (int m = 0; m < 4; ++m) { bf16_t* rowp = O + (size_t)(row0 + ai * HALF + m * 16) * ldc + col0;
#pragma unroll
                for (int bj = 0; bj < 2; ++bj) *(u32x4*)(rowp + bj * HALF) = pack8(acc[ai][bj][m][0], acc[ai][bj][m][1]); }
    }
};

struct EpiOssm {
    static constexpr bool PERM = true, AFTER_DRAIN = false;
    bf16_t* T1; const bf16_t* GS; const float* rstd;
    __device__ __forceinline__ void operator()(const f32x4 (&acc)[2][2][4][2], const Unit& u, int wr, int wc, int fr, int fq) const {
        const int row0 = u.pm * BM + wr * 64 + fr, col0 = u.pn * BM + wc * 32 + 8 * fq;
#pragma unroll
        for (int ai = 0; ai < 2; ++ai) {
            u32x4 gw[4][2]; float rsv[4];
#pragma unroll
            for (int m = 0; m < 4; ++m) { const int row = row0 + ai * HALF + m * 16; rsv[m] = rstd[row];
#pragma unroll
                for (int bj = 0; bj < 2; ++bj) gw[m][bj] = *(const u32x4*)(GS + (size_t)row * 1024 + col0 + bj * HALF); }
#pragma unroll
            for (int m = 0; m < 4; ++m) {
                const int row = row0 + ai * HALF + m * 16; const float rs = rsv[m];
#pragma unroll
                for (int bj = 0; bj < 2; ++bj) {
                    const u32x4 g4 = gw[m][bj]; const f32x4 a0 = acc[ai][bj][m][0], a1 = acc[ai][bj][m][1];
                    f32x4 r0, r1;
                    r0[0] = a0[0] * rs * bf_lo(g4.x); r0[1] = a0[1] * rs * bf_hi(g4.x); r0[2] = a0[2] * rs * bf_lo(g4.y); r0[3] = a0[3] * rs * bf_hi(g4.y);
                    r1[0] = a1[0] * rs * bf_lo(g4.z); r1[1] = a1[1] * rs * bf_hi(g4.z); r1[2] = a1[2] * rs * bf_lo(g4.w); r1[3] = a1[3] * rs * bf_hi(g4.w);
                    *(u32x4*)(T1 + (size_t)row * 1024 + col0 + bj * HALF) = pack8(r0, r1);
                }
            }
        }
    }
};

struct EpiOssmAt {
    static constexpr bool PERM = false, AFTER_DRAIN = false;
    float* T1; const bf16_t* GS; const float* rstd;
    __device__ __forceinline__ void operator()(const f32x4 (&acc)[2][2][4][2], const Unit& u, int wr, int wc, int fr, int fq) const {
        const int col0 = u.pn * BM + wc * 32 + 4 * fq;
#pragma unroll
        for (int m = 0; m < 4; ++m) {
            const int row = u.pm * BM + wr * 64 + m * 16 + fr;
            const float rs = rstd[row];
#pragma unroll
            for (int bj = 0; bj < 2; ++bj)
#pragma unroll
                for (int n = 0; n < 2; ++n) {
                    const int c = col0 + bj * HALF + n * 16;
                    const u32x2e gw = *(const u32x2e*)(GS + (size_t)row * 1024 + c);
                    const f32x4 a = acc[0][bj][m][n]; float* p = T1 + (size_t)(row - P_ROWS) * 1024 + c;
                    __hip_atomic_fetch_add(p + 0, a[0] * rs * bf_lo(gw.x), __ATOMIC_RELAXED, __HIP_MEMORY_SCOPE_AGENT); __hip_atomic_fetch_add(p + 1, a[1] * rs * bf_hi(gw.x), __ATOMIC_RELAXED, __HIP_MEMORY_SCOPE_AGENT);
                    __hip_atomic_fetch_add(p + 2, a[2] * rs * bf_lo(gw.y), __ATOMIC_RELAXED, __HIP_MEMORY_SCOPE_AGENT); __hip_atomic_fetch_add(p + 3, a[3] * rs * bf_hi(gw.y), __ATOMIC_RELAXED, __HIP_MEMORY_SCOPE_AGENT);
                }
        }
    }
};

template <bool SMP> struct EpiMerge {
    static constexpr bool PERM = true, AFTER_DRAIN = false;
    const bf16_t* T1; const float* T1S; const bf16_t* GA; bf16_t* O;
    __device__ __forceinline__ void operator()(const f32x4 (&acc)[2][2][4][2], const Unit& u, int wr, int wc, int fr, int fq) const {
        const int row0 = u.pm * BM + wr * 64 + fr, col0 = u.pn * BM + wc * 32 + 8 * fq;
#pragma unroll
        for (int ab = 0; ab < 4; ++ab) {
            const int ai = ab >> 1, m0 = (ab & 1) * 2;
            u32x4 gw[2][2], tb[2][2]; f32x4 t0[2][2], t1[2][2];
#pragma unroll
            for (int m = 0; m < 2; ++m)
#pragma unroll
                for (int bj = 0; bj < 2; ++bj) { const int row = row0 + ai * HALF + (m0 + m) * 16; const size_t o = (size_t)row * 1024 + col0 + bj * HALF;
                    gw[m][bj] = *(const u32x4*)(GA + o);
                    if constexpr (SMP) { const size_t os = (size_t)(row - P_ROWS) * 1024 + col0 + bj * HALF; t0[m][bj] = *(const f32x4*)(T1S + os); t1[m][bj] = *(const f32x4*)(T1S + os + 4); tb[m][bj] = (u32x4){0u, 0u, 0u, 0u}; }
                    else { tb[m][bj] = *(const u32x4*)(T1 + o); t0[m][bj] = (f32x4){0.f, 0.f, 0.f, 0.f}; t1[m][bj] = t0[m][bj]; } }
#pragma unroll
            for (int m = 0; m < 2; ++m)
#pragma unroll
                for (int bj = 0; bj < 2; ++bj) {
                    const size_t o = (size_t)(row0 + ai * HALF + (m0 + m) * 16) * 1024 + col0 + bj * HALF;
                    const u32x4 g4 = gw[m][bj]; const f32x4 a0 = acc[ai][bj][m0 + m][0], a1 = acc[ai][bj][m0 + m][1];
                    f32x4 x0, x1;
                    if constexpr (SMP) { x0 = t0[m][bj]; x1 = t1[m][bj]; }
                    else { const u32x4 w = tb[m][bj]; x0 = (f32x4){bf_lo(w.x), bf_hi(w.x), bf_lo(w.y), bf_hi(w.y)}; x1 = (f32x4){bf_lo(w.z), bf_hi(w.z), bf_lo(w.w), bf_hi(w.w)}; }
                    f32x4 r0, r1;
                    r0[0] = x0[0] + bf_lo(g4.x) * a0[0]; r0[1] = x0[1] + bf_hi(g4.x) * a0[1]; r0[2] = x0[2] + bf_lo(g4.y) * a0[2]; r0[3] = x0[3] + bf_hi(g4.y) * a0[3];
                    r1[0] = x1[0] + bf_lo(g4.z) * a1[0]; r1[1] = x1[1] + bf_hi(g4.z) * a1[1]; r1[2] = x1[2] + bf_lo(g4.w) * a1[2]; r1[3] = x1[3] + bf_hi(g4.w) * a1[3];
                    *(u32x4*)(O + o) = pack8(r0, r1);
                }
        }
    }
};

struct EpiWin {
    static constexpr bool PERM = true, AFTER_DRAIN = false;
    unsigned char* ws; const float* dtb; const float* ssq; PG8_LAS const float* ifq;
    static constexpr size_t O_KVP0 = 67108864ull + 131072ull, O_KVP1 = O_KVP0 + 1048576ull, O_KVP2 = O_KVP1 + 4194304ull, O_CONVP = O_KVP2 + 16777216ull, O_SSMP = O_CONVP + 73728ull,
                            O_KVS0 = O_SSMP + 2097152ull, O_KVS1 = O_KVS0 + 131072ull, O_KVS2 = O_KVS1 + 131072ull, O_CONVS = O_KVS2 + 131072ull, O_SSMS = O_CONVS + 1179648ull;
    __device__ __forceinline__ void operator()(const f32x4 (&acc)[2][2][4][2], const Unit& u, int wr, int wc, int fr, int fq) const {
        const int pn = u.pn;
        const int cl = wc * 32 + 8 * fq;
        if (pn < 46) {
            size_t boff; int ldc, ct;
            if (pn < 8) { boff = WS_Z; ldc = 2048; ct = pn; } else if (pn < 20) { boff = WS_XBC; ldc = 3072; ct = pn - 8; }
            else if (pn < 26) { boff = WS_Q; ldc = 1536; ct = pn - 20; } else if (pn < 32) { boff = WS_K; ldc = 1536; ct = pn - 26; } else if (pn < 38) { boff = WS_V; ldc = 1536; ct = pn - 32; }
            else if (pn < 42) { boff = WS_GS; ldc = 1024; ct = pn - 38; } else { boff = WS_GA; ldc = 1024; ct = pn - 42; }
            const bool rot = pn >= 20 && pn < 32, sg = pn >= 38;
            const float sc = pn < 26 ? C2Q : 1.0f;
            bf16_t* base = (bf16_t*)(ws + boff) + ct * BM + cl;
            float rsv[2][4];
#pragma unroll
            for (int ai = 0; ai < 2; ++ai)
#pragma unroll
                for (int m = 0; m < 4; ++m) rsv[ai][m] = ssq[u.pm * BM + ai * HALF + wr * 64 + m * 16 + fr];
            f32x4 fr4 = (f32x4){0.f, 0.f, 0.f, 0.f};
            if (rot) fr4 = *(PG8_LAS const f32x4*)(ifq + ((cl & 63) >> 1));
#pragma unroll
            for (int ai = 0; ai < 2; ++ai)
#pragma unroll
                for (int m = 0; m < 4; ++m) {
                    const int row = u.pm * BM + ai * HALF + wr * 64 + m * 16 + fr;
                    const float rs = __builtin_amdgcn_rsqf(rsv[ai][m] * (1.f / 1024.f) + 1e-6f);
                    f32x4 cs0 = (f32x4){1.f, 0.f, 1.f, 0.f}, cs1 = cs0;
                    if (rot) {
                        const float posf = (float)(row < P_ROWS ? (row & (SEQ_T - 1)) : SEQ_T);
                        float cc[4], sn[4];
#pragma unroll
                        for (int e = 0; e < 4; ++e) { const float ang = posf * fr4[e];
                            const float k = __builtin_rintf(ang * 0.15915494309189535f);
                            float r = __builtin_fmaf(-k, 6.2831855f, ang); r = __builtin_fmaf(-k, -1.7484555e-7f, r);
                            const float t = r * 0.15915494309189535f; cc[e] = __builtin_amdgcn_cosf(t); sn[e] = __builtin_amdgcn_sinf(t); }
                        cs0 = (f32x4){cc[0], sn[0], cc[1], sn[1]}; cs1 = (f32x4){cc[2], sn[2], cc[3], sn[3]};
                    }
#pragma unroll
                    for (int bj = 0; bj < 2; ++bj) {
                        f32x4 a0 = acc[ai][bj][m][0] * rs, a1 = acc[ai][bj][m][1] * rs;
                        if (sg) {
#pragma unroll
                            for (int j = 0; j < 4; ++j) { a0[j] = sigm(a0[j]); a1[j] = sigm(a1[j]); } }
                        if (rot) {
                            f32x4 w0, w1;
                            w0[0] = (a0[0] * cs0[0] - a0[1] * cs0[1]) * sc; w0[1] = (a0[1] * cs0[0] + a0[0] * cs0[1]) * sc;
                            w0[2] = (a0[2] * cs0[2] - a0[3] * cs0[3]) * sc; w0[3] = (a0[3] * cs0[2] + a0[2] * cs0[3]) * sc;
                            w1[0] = (a1[0] * cs1[0] - a1[1] * cs1[1]) * sc; w1[1] = (a1[1] * cs1[0] + a1[0] * cs1[1]) * sc;
                            w1[2] = (a1[2] * cs1[2] - a1[3] * cs1[3]) * sc; w1[3] = (a1[3] * cs1[2] + a1[2] * cs1[3]) * sc;
                            a0 = w0; a1 = w1;
                        }
                        *(u32x4*)(base + (size_t)row * ldc + bj * HALF) = pack8(a0, a1);
                    }
                }
        } else {
            if (wc == 0) {
                const int c0 = 8 * fq; float* DT = (float*)(ws + WS_DT);
                const f32x4 b0 = *(const f32x4*)(dtb + c0), b1 = *(const f32x4*)(dtb + c0 + 4);
#pragma unroll
                for (int ai = 0; ai < 2; ++ai)
#pragma unroll
                    for (int m = 0; m < 4; ++m) {
                        const int row = u.pm * BM + ai * HALF + wr * 64 + m * 16 + fr;
                        const float rs = __builtin_amdgcn_rsqf(ssq[row] * (1.f / 1024.f) + 1e-6f);
                        f32x4 a0 = acc[ai][0][m][0] * rs + b0, a1 = acc[ai][0][m][1] * rs + b1;
#pragma unroll
                        for (int j = 0; j < 4; ++j) { a0[j] = softplus_f(a0[j]); a1[j] = softplus_f(a1[j]); }
                        *(f32x4*)(DT + (size_t)row * 32 + c0) = a0; *(f32x4*)(DT + (size_t)row * 32 + c0 + 4) = a1;
                    }
            }
        }
    }
};

template <class Epi, class Sched, bool ALIGN_EPI = false, bool SP2 = false, bool HALFM = false>
__device__ __forceinline__ void gemm_phase(PG8_LAS unsigned char* lds, const Gemm g, const Sched& S, const Epi& E) {
    int tid_ = threadIdx.x; asm volatile("" : "+v"(tid_));
    const int tid = tid_, wid = __builtin_amdgcn_readfirstlane(tid >> 6), lane = tid & 63, wr = wid >> 2, wc = wid & 3, fr = lane & 15, fq = lane >> 4;
    const int K = g.K, nt = K / BK;
    unsigned voffA[2], voffB[2];
#pragma unroll
    for (int i = 0; i < 2; ++i) { int R, C; stage_rc(tid * 16 + i * 8192, R, C); const int Rb = Epi::PERM ? ((R & ~31) + perm32(R & 31)) : R;
        voffA[i] = (unsigned)(R * g.ld + C) * 2u; voffB[i] = (unsigned)(Rb * g.ld + C) * 2u; }
    const size_t kstep = (size_t)(BK * 2);
    const size_t hstep = (size_t)HALF * g.ld * 2;
    const size_t tstep = 2 * hstep;
    const unsigned ldsw = (unsigned)wid * 1024u;
    const int aoff = lds_byte(wr * 64 + fr, fq * 8), boff = lds_byte(wc * 32 + fr, fq * 8);
#define PG8_SA(b, h) (((b) * 2 + (h)) * HTB)
#define PG8_SB(b, h) ((4 + (b) * 2 + (h)) * HTB)
#define PG8_STAGE(bufoff, gbase, voff) do { _Pragma("unroll") for (int _i = 0; _i < 2; ++_i) \
        __builtin_amdgcn_global_load_lds((const unsigned*)((const char*)(gbase) + (voff)[_i]), (PG8_LAS unsigned*)(lds + (bufoff) + ldsw + _i * 8192), 16, 0, 0); } while (0)
#define PG8_LDA(dst, b, h) do { _Pragma("unroll") for (int m = 0; m < 4; ++m) _Pragma("unroll") for (int k = 0; k < 2; ++k) dst[m][k] = *(const PG8_LAS bf16x8*)(lds + PG8_SA(b, h) + aoff + m * 2048 + k * 1024); } while (0)
#define PG8_LDB(dst, b, h) do { _Pragma("unroll") for (int n = 0; n < 2; ++n) _Pragma("unroll") for (int k = 0; k < 2; ++k) dst[n][k] = *(const PG8_LAS bf16x8*)(lds + PG8_SB(b, h) + boff + n * 2048 + k * 1024); } while (0)
#define PG8_MMA(ai, bj, At, Bt) do { __builtin_amdgcn_s_setprio(1); _Pragma("unroll") for (int m = 0; m < 4; ++m) _Pragma("unroll") for (int n = 0; n < 2; ++n) _Pragma("unroll") for (int k = 0; k < 2; ++k) \
        acc[ai][bj][m][n] = __builtin_amdgcn_mfma_f32_16x16x32_bf16(Bt[n][k], At[m][k], acc[ai][bj][m][n], 0, 0, 0); __builtin_amdgcn_s_setprio(0); } while (0)
#define PG8_WAIT_V(n) asm volatile("s_waitcnt vmcnt(" #n ")" ::: "memory")
#define PG8_WAIT_L(n) asm volatile("s_waitcnt lgkmcnt(" #n ")" ::: "memory")
#define PG8_BAR __builtin_amdgcn_s_barrier()
#define PG8_SCHED __builtin_amdgcn_sched_barrier(0)
    Unit cur, nxt; int ui = 0;
    if (!S.next(0, cur)) return;
    f32x4 acc[2][2][4][2];
#pragma unroll
    for (int a = 0; a < 2; ++a)
#pragma unroll
        for (int b = 0; b < 2; ++b)
#pragma unroll
            for (int m = 0; m < 4; ++m)
#pragma unroll
                for (int n = 0; n < 2; ++n) acc[a][b][m][n] = (f32x4){0.f, 0.f, 0.f, 0.f};
    bf16x8 At[4][2], B0[2][2], B1[2][2];
    const char* cA = (const char*)g.A + (size_t)cur.pm * tstep + (size_t)cur.ko * 2; const char* cB = (const char*)g.Bt + (size_t)cur.pn * tstep + (size_t)cur.ko * 2;
    S.a_ready(cur);
    if constexpr (SP2) {
        PG8_STAGE(PG8_SB(0, 0), cB, voffB); PG8_STAGE(PG8_SB(0, 1), cB + hstep, voffB); PG8_STAGE(PG8_SA(0, 0), cA, voffA); PG8_STAGE(PG8_SA(0, 1), cA + hstep, voffA);
        if (wr == 1) PG8_BAR;
        PG8_WAIT_V(2); PG8_BAR;
        PG8_STAGE(PG8_SB(1, 0), cB + kstep, voffB); PG8_STAGE(PG8_SA(1, 0), cA + kstep, voffA); PG8_STAGE(PG8_SB(1, 1), cB + hstep + kstep, voffB);
        PG8_WAIT_V(6); PG8_BAR;
    } else {
        PG8_STAGE(PG8_SB(0, 0), cB, voffB); PG8_STAGE(PG8_SA(0, 0), cA, voffA); PG8_STAGE(PG8_SB(0, 1), cB + hstep, voffB); PG8_STAGE(PG8_SA(0, 1), cA + hstep, voffA);
        if (wr == 1) PG8_BAR;
        PG8_WAIT_V(4); PG8_BAR;
        PG8_STAGE(PG8_SB(1, 0), cB + kstep, voffB); PG8_STAGE(PG8_SA(1, 0), cA + kstep, voffA); PG8_STAGE(PG8_SB(1, 1), cB + hstep + kstep, voffB);
        PG8_WAIT_V(6); PG8_BAR;
    }
    for (;;) {
        const bool has_next = S.next(ui + 1, nxt);
        const char* nA = has_next ? (const char*)g.A + (size_t)nxt.pm * tstep + (size_t)nxt.ko * 2 : cA; const char* nB = has_next ? (const char*)g.Bt + (size_t)nxt.pn * tstep + (size_t)nxt.ko * 2 : cB;
        for (int t = 0; t < nt; t += 2) {
            const bool last = (t == nt - 2);
            const char* a1 = cA + (size_t)(t + 1) * kstep;
            const char* a2 = last ? nA : cA + (size_t)(t + 2) * kstep; const char* b2 = last ? nB : cB + (size_t)(t + 2) * kstep;
            const char* a3 = a2 + kstep; const char* b3 = b2 + kstep;
            if (last && has_next) S.a_ready(nxt);
            if constexpr (SP2) {
            PG8_LDB(B0, 0, 0); PG8_LDB(B1, 0, 1); PG8_SCHED; PG8_LDA(At, 0, 0); PG8_STAGE(PG8_SA(1, 1), a1 + hstep, voffA);
            PG8_WAIT_V(8); PG8_WAIT_L(0); PG8_BAR; PG8_MMA(0, 0, At, B0); PG8_MMA(0, 1, At, B1); PG8_BAR; PG8_SCHED;
            PG8_LDA(At, 0, 1); PG8_STAGE(PG8_SB(0, 0), b2, voffB); PG8_STAGE(PG8_SB(0, 1), b2 + hstep, voffB); PG8_STAGE(PG8_SA(0, 0), a2, voffA);
            PG8_WAIT_V(8); PG8_WAIT_L(0); PG8_BAR; if constexpr (!HALFM) { PG8_MMA(1, 0, At, B0); PG8_MMA(1, 1, At, B1); } PG8_BAR; PG8_SCHED;
            PG8_LDB(B0, 1, 0); PG8_LDB(B1, 1, 1); PG8_SCHED; PG8_LDA(At, 1, 0); PG8_STAGE(PG8_SA(0, 1), a2 + hstep, voffA);
            PG8_WAIT_V(8); PG8_WAIT_L(0); PG8_BAR; PG8_MMA(0, 0, At, B0); PG8_MMA(0, 1, At, B1); PG8_BAR; PG8_SCHED;
            PG8_LDA(At, 1, 1); PG8_STAGE(PG8_SB(1, 0), b3, voffB); PG8_STAGE(PG8_SB(1, 1), b3 + hstep, voffB); PG8_STAGE(PG8_SA(1, 0), a3, voffA);
            PG8_WAIT_V(8); PG8_WAIT_L(0); PG8_BAR; if constexpr (!HALFM) { PG8_MMA(1, 0, At, B0); PG8_MMA(1, 1, At, B1); } PG8_BAR; PG8_SCHED;
            } else {
            PG8_LDB(B0, 0, 0); PG8_SCHED; PG8_LDA(At, 0, 0); PG8_STAGE(PG8_SA(1, 1), a1 + hstep, voffA);
            PG8_WAIT_L(8); PG8_BAR; PG8_WAIT_L(0); PG8_MMA(0, 0, At, B0); PG8_BAR; PG8_SCHED;
            PG8_LDB(B1, 0, 1); PG8_STAGE(PG8_SB(0, 0), b2, voffB);
            PG8_BAR; PG8_WAIT_L(0); PG8_MMA(0, 1, At, B1); PG8_BAR;
            PG8_LDA(At, 0, 1); PG8_STAGE(PG8_SA(0, 0), a2, voffA);
            PG8_BAR; PG8_WAIT_L(0); PG8_MMA(1, 0, At, B0); PG8_BAR; PG8_SCHED;
            PG8_STAGE(PG8_SB(0, 1), b2 + hstep, voffB);
            PG8_WAIT_V(6); PG8_BAR; PG8_MMA(1, 1, At, B1); PG8_BAR;
            PG8_LDB(B0, 1, 0); PG8_SCHED; PG8_LDA(At, 1, 0); PG8_STAGE(PG8_SA(0, 1), a2 + hstep, voffA);
            PG8_WAIT_L(8); PG8_BAR; PG8_WAIT_L(0); PG8_MMA(0, 0, At, B0); PG8_BAR; PG8_SCHED;
            PG8_LDB(B1, 1, 1); PG8_STAGE(PG8_SB(1, 0), b3, voffB);
            PG8_BAR; PG8_WAIT_L(0); PG8_MMA(0, 1, At, B1); PG8_BAR;
            PG8_LDA(At, 1, 1); PG8_STAGE(PG8_SA(1, 0), a3, voffA);
            PG8_BAR; PG8_WAIT_L(0); PG8_MMA(1, 0, At, B0); PG8_BAR; PG8_SCHED;
            PG8_STAGE(PG8_SB(1, 1), b3 + hstep, voffB);
            PG8_WAIT_V(6); PG8_BAR; PG8_MMA(1, 1, At, B1); PG8_BAR;
            }
        }
        if constexpr (ALIGN_EPI) { if (wr == 0) PG8_BAR; }
        if constexpr (!Epi::AFTER_DRAIN) { E(acc, cur, wr, wc, fr, fq); S.done(cur); }
        if (!has_next) break;
#pragma unroll
        for (int a = 0; a < 2; ++a)
#pragma unroll
            for (int b = 0; b < 2; ++b)
#pragma unroll
                for (int m = 0; m < 4; ++m)
#pragma unroll
                    for (int n = 0; n < 2; ++n) acc[a][b][m][n] = (f32x4){0.f, 0.f, 0.f, 0.f};
        cur = nxt; cA = nA; cB = nB; ++ui;
        if constexpr (ALIGN_EPI) { if (wr == 1) PG8_BAR; }
    }
    PG8_WAIT_V(0);
    if constexpr (!ALIGN_EPI) { if (wr == 0) PG8_BAR; }
    PG8_BAR;
    if constexpr (Epi::AFTER_DRAIN) { E.fused(acc, cur, wr, wc, fr, fq, lds, wid, lane); S.done(cur); }
#undef PG8_SA
#undef PG8_SB
#undef PG8_STAGE
#undef PG8_LDA
#undef PG8_LDB
#undef PG8_MMA
#undef PG8_WAIT_V
#undef PG8_WAIT_L
#undef PG8_BAR
#undef PG8_SCHED
}
}


constexpr int RING_OFF = 0, RING_BYTES = 139264;
constexpr int LDSCTL_OFF = RING_BYTES, MISC_OFF = LDSCTL_OFF + 320;
constexpr int LDS_BYTES = 147456;
static_assert(MISC_OFF + 128 <= LDS_BYTES, "LDS map");

#define GAS __attribute__((address_space(1)))
#define LAS __attribute__((address_space(3)))
typedef unsigned short bf16;
typedef unsigned v4u __attribute__((ext_vector_type(4)));
typedef unsigned v2u __attribute__((ext_vector_type(2)));
typedef float f32x4 __attribute__((ext_vector_type(4)));
typedef float f32x16 __attribute__((ext_vector_type(16)));
typedef short bf16x8 __attribute__((ext_vector_type(8)));
typedef short s16x4 __attribute__((ext_vector_type(4)));
typedef GAS unsigned gu32;
#define RLX_AGENT __ATOMIC_RELAXED, __HIP_MEMORY_SCOPE_AGENT
#define LDS_WAIT() asm volatile("s_waitcnt lgkmcnt(0)" ::: "memory")
#define VM_WAIT() asm volatile("s_waitcnt vmcnt(0)" ::: "memory")
__device__ __forceinline__ unsigned f2bf(float f) { unsigned u = __builtin_bit_cast(unsigned, f); return (u + 0x7fffu + ((u >> 16) & 1u)) >> 16; }
__device__ __forceinline__ unsigned pk2(float lo, float hi) { return f2bf(lo) | (f2bf(hi) << 16); }
__device__ __forceinline__ float bflo(unsigned w) { return __builtin_bit_cast(float, w << 16); }
__device__ __forceinline__ float bfhi(unsigned w) { return __builtin_bit_cast(float, w & 0xffff0000u); }
using pg8::ex2; using pg8::sigm; using pg8::silu_f;
__device__ __forceinline__ int fresh_lane() { int l = threadIdx.x & 63; asm volatile("" : "+v"(l)); return l; }
__device__ __forceinline__ int fresh_tid() { int t = threadIdx.x; asm volatile("" : "+v"(t)); return t; }
#define XB_TMO      128
#define XB_XCNT(j)  (256  + 64 * (j))
#define XB_XSUB(j)  (1280 + 64 * (j))
#define XB_XGEN(j)  (2304 + 64 * (j))
#define XB_TOP      3328
#define XB_TOPGEN   3392
#define XCD_BAR_WORDS 3456
#define XB_SPIN_CAP (1u << 18)

__device__ __forceinline__ unsigned xb_ld(unsigned* p)              { return __hip_atomic_load(p, __ATOMIC_RELAXED, __HIP_MEMORY_SCOPE_AGENT); }
__device__ __forceinline__ unsigned xb_add(unsigned* p, unsigned v) { return __hip_atomic_fetch_add(p, v, __ATOMIC_RELAXED, __HIP_MEMORY_SCOPE_AGENT); }
__device__ __forceinline__ unsigned xb_xcc_id() { return (unsigned)__builtin_amdgcn_s_getreg((3 << 11) | 20) & 0xFu; }
#define XB_SPIN(cond, bar) do { unsigned _sp = 0; while (cond) { __builtin_amdgcn_s_sleep(1); \
    if ((++_sp & 255u) == 0u) { if (xb_ld(&(bar)[XB_TMO])) break; if (_sp > XB_SPIN_CAP) { atomicAdd(&(bar)[XB_TMO], 1u); break; } } } } while (0)

struct XcdBarrier {
    unsigned* bar; unsigned x;
    volatile LAS unsigned* st;
};

__device__ __forceinline__ XcdBarrier xcd_barrier_post(unsigned* bar, volatile LAS unsigned* st) {
    XcdBarrier b; b.bar = bar; b.x = xb_xcc_id(); b.st = st;
    if (threadIdx.x == 0) (void)xb_add(&bar[XB_XCNT(b.x)], 1u);
    return b;
}
__device__ __forceinline__ void xcd_barrier_complete(unsigned* bar, unsigned x, unsigned& nloc, unsigned& nx) {
    const unsigned G = gridDim.x * gridDim.y * gridDim.z;
    unsigned sum, cnt, mine, sp = 0u;
    for (;;) {
        sum = 0u; cnt = 0u; mine = 0u;
#pragma unroll
        for (unsigned j = 0; j < 16; ++j) { const unsigned c = xb_ld(&bar[XB_XCNT(j)]); sum += c; cnt += (c > 0u) ? 1u : 0u; mine = (j == x) ? c : mine; }
        if (sum == G) break;
        __builtin_amdgcn_s_sleep(1);
        if ((++sp & 255u) == 0u) { if (xb_ld(&bar[XB_TMO])) break; if (sp > XB_SPIN_CAP) { atomicAdd(&bar[XB_TMO], 1u); break; } }
    }
    nloc = mine > 0u ? mine : 1u; nx = cnt > 0u ? cnt : 1u;
}

__device__ __forceinline__ void xcd_barrier(const XcdBarrier& b) {
    asm volatile("s_waitcnt vmcnt(0)" ::: "memory");
    __syncthreads();
    if (threadIdx.x == 0) {
        unsigned* bar = b.bar;
        __builtin_amdgcn_s_waitcnt(0);
        unsigned nloc = b.st[0], nx = b.st[1];
        if (nloc == 0u) { xcd_barrier_complete(bar, b.x, nloc, nx); b.st[0] = nloc; b.st[1] = nx; }
        const unsigned old = xb_add(&bar[XB_XSUB(b.x)], 1u);
        const unsigned gen = old / nloc;
        if (old + 1u == (gen + 1u) * nloc) {
            __builtin_amdgcn_fence(__ATOMIC_RELEASE, "agent");
            asm volatile("s_waitcnt vmcnt(0)" ::: "memory");
            const unsigned og = xb_add(&bar[XB_TOP], 1u);
            const unsigned tg = og / nx;
            if (og + 1u == (tg + 1u) * nx) xb_add(&bar[XB_TOPGEN], 1u);
            else XB_SPIN(xb_ld(&bar[XB_TOPGEN]) == tg, bar);
            __builtin_amdgcn_fence(__ATOMIC_ACQUIRE, "agent");
            xb_add(&bar[XB_XGEN(b.x)], 1u);
            asm volatile("s_waitcnt vmcnt(0)" ::: "memory");
        } else {
            XB_SPIN(xb_ld(&bar[XB_XGEN(b.x)]) == gen, bar);
            __builtin_amdgcn_fence(__ATOMIC_ACQUIRE, "agent");
            asm volatile("s_waitcnt vmcnt(0)" ::: "memory");
        }
    }
    __syncthreads();
}

struct Args { const float* in[32]; float* out; unsigned char* ws; };
struct Frame {
    LAS unsigned char* lds;
    volatile LAS unsigned* MISC;
    gu32* ctl;
    int tid, lane, wave, G;
};
__device__ const float INV_FREQ[32] = {1.000000000e+00f, 7.498942614e-01f, 5.623413324e-01f, 4.216965139e-01f, 3.162277639e-01f, 2.371373773e-01f, 1.778279394e-01f, 1.333521307e-01f,
    1.000000015e-01f, 7.498941571e-02f, 5.623413250e-02f, 4.216965288e-02f, 3.162277490e-02f, 2.371373773e-02f, 1.778279431e-02f, 1.333521493e-02f,
    9.999999776e-03f, 7.498941850e-03f, 5.623413250e-03f, 4.216964822e-03f, 3.162277630e-03f, 2.371373586e-03f, 1.778279431e-03f, 1.333521446e-03f,
    1.000000047e-03f, 7.498942432e-04f, 5.623413017e-04f, 4.216965172e-04f, 3.162277571e-04f, 2.371373703e-04f, 1.778279402e-04f, 1.333521504e-04f};

__device__ __forceinline__ float wave_sum(float v) {
#pragma unroll
    for (int o = 1; o < 64; o <<= 1) v += __shfl_xor(v, o);
    return v;
}
__device__ __forceinline__ void sincos_d(double a, double& s, double& c) {
    const double k = __builtin_rint(a * 0.15915494309189535);
    double r = __builtin_fma(-k, 6.283185307179586, a);
    r = __builtin_fma(-k, 2.4492935982947064e-16, r);
    const double r2 = r * r;
    double sa = 1.0, ca = 1.0;
#pragma unroll
    for (int n = 15; n >= 1; --n) { sa = 1.0 - sa * r2 * (1.0 / (double)((2 * n) * (2 * n + 1))); ca = 1.0 - ca * r2 * (1.0 / (double)((2 * n - 1) * (2 * n))); }
    s = sa * r; c = ca;
}

__device__ __forceinline__ void p0_item(const float* colp, int ldw, const float* gain, int K, bf16* WT, int v0, int k0, LAS float* scr, int lane) {
#pragma unroll
    for (int i = 0; i < 32; ++i) { const int kk = 2 * i + (lane >> 5); float w = colp ? colp[(size_t)(k0 + kk) * ldw] : 0.f; if (gain) w *= gain[k0 + kk]; scr[kk * 33 + (lane & 31)] = w; }
    LDS_WAIT(); asm volatile("" ::: "memory");
    const int c = lane & 7;
#pragma unroll
    for (int j = 0; j < 4; ++j) { const int n = (lane >> 3) + 8 * j; const LAS float* s = scr + (8 * c) * 33 + n;
        v4u o; o.x = pk2(s[0 * 33], s[1 * 33]); o.y = pk2(s[2 * 33], s[3 * 33]); o.z = pk2(s[4 * 33], s[5 * 33]); o.w = pk2(s[6 * 33], s[7 * 33]);
        *(GAS v4u*)(WT + (size_t)(v0 + n) * K + k0 + 8 * c) = o; }
    LDS_WAIT(); asm volatile("" ::: "memory");
}
__device__ __forceinline__ int win_src(int v) {
    if (v < 5120) return v;
    if (v < 8192) { const int isk = v >= 6656, w = v - (isk ? 6656 : 5120), head = w >> 6, j = w & 63, dim = (j & 1) ? 32 + (j >> 1) : (j >> 1); return (isk ? 6688 : 5152) + head * 64 + dim; }
    if (v < 9728) return 8224 + (v - 8192);
    if (v < 10752) return 9760 + (v - 9728);
    if (v < 11776) return 10784 + (v - 10752);
    if (v < 11808) return 5120 + (v - 11776);
    return -1;
}
__device__ __forceinline__ void norm_row_bf16(const float* xrow, const float* gain, bf16* orow, int lane) {
    const GAS f32x4* xr = (const GAS f32x4*)xrow + lane; const GAS f32x4* gr = (const GAS f32x4*)gain + lane;
    f32x4 v[4]; float s = 0.f;
#pragma unroll
    for (int j = 0; j < 4; ++j) { v[j] = xr[64 * j]; s += (v[j].x * v[j].x + v[j].y * v[j].y) + (v[j].z * v[j].z + v[j].w * v[j].w); }
    const float rstd = 1.0f / sqrtf(wave_sum(s) * (1.f / 1024.f) + EPS);
    GAS unsigned long long* o8 = (GAS unsigned long long*)orow + lane;
#pragma unroll
    for (int j = 0; j < 4; ++j) { const f32x4 g = gr[64 * j];
        o8[64 * j] = (unsigned long long)pk2(v[j].x * rstd * g.x, v[j].y * rstd * g.y) | ((unsigned long long)pk2(v[j].z * rstd * g.z, v[j].w * rstd * g.w) << 32); }
}
__device__ __forceinline__ void norm_row_f32(const float* xrow, const float* gain, float* orow, int lane) {
    const GAS f32x4* xr = (const GAS f32x4*)xrow + lane; const GAS f32x4* gr = (const GAS f32x4*)gain + lane;
    f32x4 v[4]; float s = 0.f;
#pragma unroll
    for (int j = 0; j < 4; ++j) { v[j] = xr[64 * j]; s += (v[j].x * v[j].x + v[j].y * v[j].y) + (v[j].z * v[j].z + v[j].w * v[j].w); }
    const float rstd = 1.0f / sqrtf(wave_sum(s) * (1.f / 1024.f) + EPS);
    GAS f32x4* o = (GAS f32x4*)orow + lane;
#pragma unroll
    for (int j = 0; j < 4; ++j) { const f32x4 g = gr[64 * j]; o[64 * j] = v[j] * rstd * g; }
}
template <bool OUTF32> __device__ __forceinline__ void norm_rows4(const float* x, const float* gain, void* out, size_t m, size_t step, int lane) {
    f32x4 v[4][4]; float s[4];
#pragma unroll
    for (int r = 0; r < 4; ++r) { const GAS f32x4* xr = (const GAS f32x4*)(x + (m + r * step) * 1024) + lane;
#pragma unroll
        for (int j = 0; j < 4; ++j) v[r][j] = xr[64 * j]; }
    f32x4 g[4];
#pragma unroll
    for (int j = 0; j < 4; ++j) g[j] = ((const GAS f32x4*)gain)[lane + 64 * j];
#pragma unroll
    for (int r = 0; r < 4; ++r) { float q = 0.f;
#pragma unroll
        for (int j = 0; j < 4; ++j) q += (v[r][j].x * v[r][j].x + v[r][j].y * v[r][j].y) + (v[r][j].z * v[r][j].z + v[r][j].w * v[r][j].w);
        s[r] = q; }
#pragma unroll
    for (int o = 1; o < 64; o <<= 1) {
#pragma unroll
        for (int r = 0; r < 4; ++r) s[r] += __shfl_xor(s[r], o); }
#pragma unroll
    for (int r = 0; r < 4; ++r) { const float rstd = 1.0f / sqrtf(s[r] * (1.f / 1024.f) + EPS);
        if (OUTF32) { GAS f32x4* o = (GAS f32x4*)((float*)out + (m + r * step) * 1024) + lane;
#pragma unroll
            for (int j = 0; j < 4; ++j) o[64 * j] = v[r][j] * rstd * g[j]; }
        else { GAS unsigned long long* o8 = (GAS unsigned long long*)((bf16*)out + (m + r * step) * 1024) + lane;
#pragma unroll
            for (int j = 0; j < 4; ++j) o8[64 * j] = (unsigned long long)pk2(v[r][j].x * rstd * g[j].x, v[r][j].y * rstd * g[j].y) | ((unsigned long long)pk2(v[r][j].z * rstd * g[j].z, v[r][j].w * rstd * g[j].w) << 32); }
    }
}
__device__ __forceinline__ void final_rows4(const bf16* h, const float* gain, float* out, size_t m, size_t step, int nrows, int lane) {
    v4u v[4][2]; float s[4];
#pragma unroll
    for (int r = 0; r < 4; ++r) { const size_t mm = m + (r < nrows ? r : 0) * step; v[r][0] = ((const GAS v4u*)(h + mm * 1024))[lane]; v[r][1] = ((const GAS v4u*)(h + mm * 1024))[lane + 64]; }
    f32x4 g[4];
#pragma unroll
    for (int j = 0; j < 2; ++j) { g[2 * j] = ((const GAS f32x4*)gain)[128 * j + 2 * lane]; g[2 * j + 1] = ((const GAS f32x4*)gain)[128 * j + 2 * lane + 1]; }
    float x[4][16];
#pragma unroll
    for (int r = 0; r < 4; ++r) { float q = 0.f;
#pragma unroll
        for (int j = 0; j < 2; ++j) { const v4u w = v[r][j];
            x[r][8 * j + 0] = bflo(w.x); x[r][8 * j + 1] = bfhi(w.x); x[r][8 * j + 2] = bflo(w.y); x[r][8 * j + 3] = bfhi(w.y); x[r][8 * j + 4] = bflo(w.z); x[r][8 * j + 5] = bfhi(w.z); x[r][8 * j + 6] = bflo(w.w); x[r][8 * j + 7] = bfhi(w.w); }
#pragma unroll
        for (int e = 0; e < 16; ++e) q += x[r][e] * x[r][e];
        s[r] = q; }
#pragma unroll
    for (int o = 1; o < 64; o <<= 1) {
#pragma unroll
        for (int r = 0; r < 4; ++r) s[r] += __shfl_xor(s[r], o); }
#pragma unroll
    for (int r = 0; r < 4; ++r) if (r < nrows) { const float rstd = 1.0f / sqrtf(s[r] * (1.f / 1024.f) + EPS);
        GAS f32x4* o = (GAS f32x4*)(out + (m + r * step) * 1024);
#pragma unroll
        for (int j = 0; j < 2; ++j) { o[128 * j + 2 * lane] = (f32x4){x[r][8 * j] * rstd * g[2 * j][0], x[r][8 * j + 1] * rstd * g[2 * j][1], x[r][8 * j + 2] * rstd * g[2 * j][2], x[r][8 * j + 3] * rstd * g[2 * j][3]};
            o[128 * j + 2 * lane + 1] = (f32x4){x[r][8 * j + 4] * rstd * g[2 * j + 1][0], x[r][8 * j + 5] * rstd * g[2 * j + 1][1], x[r][8 * j + 6] * rstd * g[2 * j + 1][2], x[r][8 * j + 7] * rstd * g[2 * j + 1][3]}; }
    }
}
__device__ __forceinline__ void norm_phase(const Frame& F, const float* HR, const float* gain, bf16* U) {
    const int gw = blockIdx.x * NWAVES + F.wave, NGW = F.G * NWAVES;
    for (int m = gw; m < M_REAL; m += NGW) norm_row_bf16(HR + (size_t)m * 1024, gain, U + (size_t)m * 1024, fresh_lane());
}

__device__ __forceinline__ void p0_prologue(const Frame& F, const Args& A) {
    unsigned char* ws = A.ws;
    LAS float* scr = (LAS float*)(F.lds + RING_OFF + F.wave * 16384);
    const int gw = blockIdx.x * NWAVES + F.wave, NGW = F.G * NWAVES, lane = fresh_lane();
    constexpr int NK[10] = {16, 44, 16, 32, 8, 16, 16, 44, 16, 4};
    constexpr int NN[10] = {176, 32, 376, 32, 32, 32, 176, 32, 32, 32};
    int total = 0;
#pragma unroll
    for (int k = 0; k < 10; ++k) total += NK[k] * NN[k];
    for (int it = gw; it < total; it += NGW) {
        int r = it, kind = 0;
#pragma unroll
        for (int k = 0; k < 9; ++k) { if (kind == k && r >= NK[k] * NN[k]) { r -= NK[k] * NN[k]; kind = k + 1; } }
        int nn = 32, K = 1024, ldw = 1024; const float* src = nullptr; const float* gain = nullptr; bf16* WT = nullptr;
        switch (kind) {
            case 0: nn = 176; K = 1024; ldw = 2816; WT = (bf16*)(ws + WS_W1A); break;
            case 1: nn = 32; K = 2816; ldw = 1024; src = A.in[12]; WT = (bf16*)(ws + WS_W2A); break;
            case 2: nn = 376; K = 1024; ldw = 11808; src = A.in[14]; gain = A.in[13]; WT = (bf16*)(ws + WS_WIN); break;
            case 3: nn = 32; K = 2048; ldw = 1024; src = A.in[21]; gain = A.in[20]; WT = (bf16*)(ws + WS_WOS); break;
            case 4: nn = 32; K = 512; ldw = 1024; src = A.in[22]; WT = (bf16*)(ws + WS_WOA); break;
            case 5: nn = 32; K = 1024; ldw = 1024; src = A.in[23]; WT = (bf16*)(ws + WS_WOUT); break;
            case 6: nn = 176; K = 1024; ldw = 2816; gain = A.in[24]; WT = (bf16*)(ws + WS_W1B); break;
            case 7: nn = 32; K = 2816; ldw = 1024; src = A.in[27]; WT = (bf16*)(ws + WS_W2B); break;
            case 8: nn = 32; K = 1024; ldw = 1024; src = A.in[29]; gain = A.in[28]; WT = (bf16*)(ws + WS_WPG); break;
            default: nn = 32; K = 256; ldw = 1024; src = A.in[30]; WT = (bf16*)(ws + WS_WPP); break;
        }
        const int kb = r / nn, nb = r % nn, v = nb * 32 + (lane & 31);
        const float* colp;
        if (kind == 0 || kind == 6) { const int tile = v >> 8, w = v & 255; colp = (w < 128 ? A.in[kind == 0 ? 10 : 25] : A.in[kind == 0 ? 11 : 26]) + tile * 128 + (w & 127); }
        else if (kind == 2) { const int sc = win_src(v); colp = sc >= 0 ? src + sc : nullptr; }
        else colp = src + v;
        p0_item(colp, ldw, gain, K, WT, nb * 32, kb * 64, scr, lane);
    }
    {
        float* cs = (float*)(ws + WS_CS);
        const int gt = blockIdx.x * (NWAVES * 64) + fresh_tid(), NT = F.G * NWAVES * 64;
        for (int e = gt; e < 8193 * 32; e += NT) { const int pos = e >> 5, i = e & 31; const float ang = (float)pos * INV_FREQ[i];
            double s, c; sincos_d((double)ang, s, c); cs[(size_t)pos * 64 + (i >> 1) * 4 + (i & 1) * 2 + 0] = (float)c; cs[(size_t)pos * 64 + (i >> 1) * 4 + (i & 1) * 2 + 1] = (float)s; }
    }
    {
        bf16* U = (bf16*)(ws + WS_U); bf16* PB = (bf16*)(ws + WS_PB); bf16* YG = (bf16*)(ws + WS_YG); bf16* AO = (bf16*)(ws + WS_AO);
        for (int m = gw; m + 3 * NGW < P_ROWS; m += 4 * NGW) {
            f32x4 p[4];
#pragma unroll
            for (int r = 0; r < 4; ++r) p[r] = ((const GAS f32x4*)(A.in[7] + ((size_t)m + (size_t)r * NGW) * 256))[lane];
            norm_rows4<false>(A.in[0], A.in[9], U, (size_t)m, (size_t)NGW, lane);
#pragma unroll
            for (int r = 0; r < 4; ++r) { const size_t mm = (size_t)m + (size_t)r * NGW;
                ((GAS v2u*)(PB + mm * 256))[lane] = (v2u){pk2(p[r].x, p[r].y), pk2(p[r].z, p[r].w)};
                if (lane < 3) ((float*)(ws + WS_SQ2))[(size_t)lane * M_PAD + mm] = 0.f; }
        }
        const int mrest = (P_ROWS / (4 * NGW)) * (4 * NGW);
        for (int m = mrest + gw; m < M_PAD; m += NGW) {
            if (m < M_REAL) {
                const float* xr = m < P_ROWS ? A.in[0] + (size_t)m * 1024 : A.in[1] + (size_t)(m - P_ROWS) * 1024;
                norm_row_bf16(xr, A.in[9], U + (size_t)m * 1024, lane);
                const float* pr = m < P_ROWS ? A.in[7] + (size_t)m * 256 : A.in[8] + (size_t)(m - P_ROWS) * 256;
                const f32x4 p = ((const GAS f32x4*)pr)[lane];
                ((GAS v2u*)(PB + (size_t)m * 256))[lane] = (v2u){pk2(p.x, p.y), pk2(p.z, p.w)};
            } else {
                const v4u z = (v4u){0u, 0u, 0u, 0u};
                ((GAS v4u*)(U + (size_t)m * 1024))[lane] = z; ((GAS v4u*)(U + (size_t)m * 1024))[lane + 64] = z;
                if (lane < 32) ((GAS v4u*)(PB + (size_t)m * 256))[lane] = z;
#pragma unroll
                for (int j = 0; j < 4; ++j) ((GAS v4u*)(YG + (size_t)m * 2048))[lane + 64 * j] = z;
                ((GAS v4u*)(AO + (size_t)m * 512))[lane] = z;
                if (lane == 0) ((float*)(ws + WS_RSTD))[m] = 0.f;
            }
            if (lane < 3) ((float*)(ws + WS_SQ2))[(size_t)lane * M_PAD + m] = 0.f;
            if (m >= P_ROWS) {
                GAS f32x4* hr = (GAS f32x4*)((float*)(ws + WS_HR) + (size_t)m * 1024) + lane; GAS f32x4* t1 = (GAS f32x4*)((float*)(ws + WS_T1S) + (size_t)(m - P_ROWS) * 1024) + lane;
#pragma unroll
                for (int j = 0; j < 4; ++j) { hr[64 * j] = m < M_REAL ? ((const GAS f32x4*)(A.in[1] + (size_t)(m - P_ROWS) * 1024))[lane + 64 * j] : (f32x4){0.f, 0.f, 0.f, 0.f}; t1[64 * j] = (f32x4){0.f, 0.f, 0.f, 0.f}; }
            }
        }
    }
}
__device__ __forceinline__ void sample_norm_phase(const Frame& F, const float* HR, bf16* HB, float* ssq) {
    const int gw = blockIdx.x * NWAVES + F.wave, NGW = F.G * NWAVES, lane = fresh_lane();
    for (int m = P_ROWS + gw; m < M_REAL; m += NGW) {
        const GAS f32x4* xr = (const GAS f32x4*)(HR + (size_t)m * 1024) + lane; float s = 0.f;
        GAS unsigned long long* o8 = (GAS unsigned long long*)(HB + (size_t)m * 1024) + lane;
#pragma unroll
        for (int j = 0; j < 4; ++j) { const f32x4 v = xr[64 * j]; s += (v.x * v.x + v.y * v.y) + (v.z * v.z + v.w * v.w);
            o8[64 * j] = (unsigned long long)pk2(v.x, v.y) | ((unsigned long long)pk2(v.z, v.w) << 32); }
        s = wave_sum(s);
        if (lane == 0) ssq[m] = s;
    }
}

typedef short v4i16_t __attribute__((ext_vector_type(4)));
constexpr float LOG2E = 1.4426950408889634f;
constexpr size_t O_KVS0 = pg8::EpiWin::O_KVS0, O_KVS1 = pg8::EpiWin::O_KVS1, O_KVS2 = pg8::EpiWin::O_KVS2, O_CONVS = pg8::EpiWin::O_CONVS, O_SSMS = pg8::EpiWin::O_SSMS, O_SSMP = pg8::EpiWin::O_SSMP;
__device__ __forceinline__ s16x4 trr(LAS unsigned char* p) { return __builtin_bit_cast(s16x4, __builtin_amdgcn_ds_read_tr16_b64_v4i16((LAS v4i16_t*)p)); }
__device__ __forceinline__ bf16x8 cat8(s16x4 lo, s16x4 hi) { return (bf16x8){lo[0], lo[1], lo[2], lo[3], hi[0], hi[1], hi[2], hi[3]}; }
__device__ __forceinline__ bf16x8 packf8(float a0, float a1, float a2, float a3, float a4, float a5, float a6, float a7) {
    v4u w; w.x = pg8::cvt_pk_bf16(a0, a1); w.y = pg8::cvt_pk_bf16(a2, a3); w.z = pg8::cvt_pk_bf16(a4, a5); w.w = pg8::cvt_pk_bf16(a6, a7); return __builtin_bit_cast(bf16x8, w); }
#define MFMA32(a, b, c) __builtin_amdgcn_mfma_f32_32x32x16_bf16((a), (b), (c), 0, 0, 0)

__device__ __forceinline__ void conv_prepass(const Frame& F, const Args& A) {
    unsigned char* ws = A.ws;
    const int gt = blockIdx.x * (NWAVES * 64) + fresh_tid(), NT = F.G * NWAVES * 64, nper = NT / 128, nthr = nper * 128;
    if (gt >= nthr) return;
    const int cc = 256 + gt % 128, c0 = 8 * cc;
    float cw0[8], cw1[8], cw2[8], cw3[8], cbs[8];
#pragma unroll
    for (int e = 0; e < 8; ++e) { cw0[e] = A.in[15][c0 + e]; cw1[e] = A.in[15][3072 + c0 + e]; cw2[e] = A.in[15][2 * 3072 + c0 + e]; cw3[e] = A.in[15][3 * 3072 + c0 + e]; cbs[e] = A.in[16][c0 + e]; }
    const bf16* XB = (const bf16*)(ws + WS_XBC) + c0; bf16* XC = (bf16*)(ws + WS_XC) + c0;
    for (int seg = gt / 128; seg < P_ROWS / 16; seg += nper) {
        const int row0 = seg * 16, tb = row0 & (SEQ_T - 1);
        float r0[8], r1[8], r2[8], cur[8];
#pragma unroll
        for (int i = 0; i < 19; ++i) {
            const v4u rw = (tb - 3 + i >= 0) ? *(const GAS v4u*)(XB + (size_t)(row0 - 3 + i) * 3072) : (v4u){0u, 0u, 0u, 0u};
            cur[0] = bflo(rw.x); cur[1] = bfhi(rw.x); cur[2] = bflo(rw.y); cur[3] = bfhi(rw.y); cur[4] = bflo(rw.z); cur[5] = bfhi(rw.z); cur[6] = bflo(rw.w); cur[7] = bfhi(rw.w);
            if (i >= 3) {
                float y[8];
#pragma unroll
                for (int e = 0; e < 8; ++e) { const float v = cbs[e] + cw0[e] * r0[e] + cw1[e] * r1[e] + cw2[e] * r2[e] + cw3[e] * cur[e]; y[e] = silu_f(v); }
                *(GAS bf16x8*)(XC + (size_t)(row0 + i - 3) * 3072) = packf8(y[0], y[1], y[2], y[3], y[4], y[5], y[6], y[7]);
            }
#pragma unroll
            for (int e = 0; e < 8; ++e) { r0[e] = r1[e]; r1[e] = r2[e]; r2[e] = cur[e]; }
        }
    }
}

constexpr int XS_ = 144, BS_ = 272;
constexpr int L_XT = 0, L_XST = L_XT + 128 * XS_, L_BT = L_XST + 128 * XS_, L_CT = L_BT + 128 * BS_, L_ST = L_CT + 128 * BS_, L_ARR = L_ST + 64 * BS_, L_CWL = L_ARR + 3072, L_HALO = L_CWL + 1280, L_SSD_END = L_HALO + 8 * 2 * 3 * XS_;
static_assert(L_SSD_END <= RING_BYTES, "SSD LDS map");

__device__ __forceinline__ void ssd_stream(const Frame& F, const Args& A, int sidx) {
    unsigned char* ws = A.ws;
    const int lane = fresh_lane(), w = F.wave, tid = fresh_tid(), r32 = lane & 31, hh = lane >> 5;
    const int qq = (lane & 15) >> 2, pp = lane & 3, cb16 = (lane >> 4) & 1;
    const int pairi = (sidx & 7) * 4 + (sidx >> 6), b = pairi >> 2, g = pairi & 3, hd = g * 8 + ((sidx >> 3) & 7);
    LAS unsigned char* XT = F.lds + L_XT; LAS unsigned char* XST = F.lds + L_XST; LAS unsigned char* BT = F.lds + L_BT; LAS unsigned char* CT = F.lds + L_CT; LAS unsigned char* ST = F.lds + L_ST;
    const float a2 = -ex2(A.in[18][hd] * LOG2E) * LOG2E;
    const float Dsk = A.in[19][hd];
    const int pt = w >> 2, lt = w < 4 ? w : 7 - w, nt = w & 3;
    f32x16 st;
#pragma unroll
    for (int i = 0; i < 16; ++i) st[i] = 0.f;
    const GAS unsigned char* XCg = (const GAS unsigned char*)(ws + WS_XC) + (size_t)b * SEQ_T * 3072 * 2;
    const GAS unsigned char* XBg = (const GAS unsigned char*)(ws + WS_XBC) + (size_t)b * SEQ_T * 3072 * 2;
    const GAS unsigned char* DTg = (const GAS unsigned char*)(ws + WS_DT) + ((size_t)b * SEQ_T * 32 + hd) * 4;
    const GAS unsigned char* Zg = (const GAS unsigned char*)(ws + WS_Z) + (size_t)b * SEQ_T * 2048 * 2;
    GAS unsigned char* YGg = (GAS unsigned char*)(ws + WS_YG) + (size_t)b * SEQ_T * 2048 * 2;
    GAS unsigned char* SSQg = (GAS unsigned char*)(ws + WS_SSQ) + (size_t)b * SEQ_T * 64 * 4;
    const unsigned xoff = (unsigned)((tid >> 3) * 3072 + hd * 64 + 8 * (tid & 7)) * 2u;
    const unsigned boff = (unsigned)((tid >> 4) * 3072 + 2048 + g * 128 + 8 * (tid & 15)) * 2u;
    const int xdst = (tid >> 3) * XS_ + 16 * (tid & 7), bdst = (tid >> 4) * BS_ + 16 * (tid & 15);
    const unsigned doff = (unsigned)(2 * lane) * 128u;
    const int hrow = 8 * w - 3 + (lane >> 3);
    const unsigned hoff = (unsigned)(hd * 64 + 8 * (lane & 7)) * 2u;
    LAS unsigned char* HAL = F.lds + L_HALO + w * (2 * 3 * XS_);
    LAS float* CWL = (LAS float*)(F.lds + L_CWL);
    if (tid < 320) CWL[tid] = tid < 256 ? A.in[15][(tid >> 6) * 3072 + hd * 64 + (tid & 63)] : A.in[16][hd * 64 + (tid & 63)];
    const int lcol = 32 * lt + r32;
    const unsigned zoff = (unsigned)(lcol * 2048 + hd * 64 + 32 * pt + 4 * hh) * 2u;
    const unsigned soff = (unsigned)(lcol * 64 + hd * 2 + pt) * 4u;
    v4u pfx[2], pfh[2], pfb[4], pfc[4]; float pd0 = 0.f, pd1 = 0.f;
#pragma unroll
    for (int i = 0; i < 2; ++i) { pfx[i] = *(const GAS v4u*)(XBg + (size_t)i * (64 * 6144) + xoff);
        pfh[i] = (lane < 24 && hrow + 64 * i >= 0) ? *(const GAS v4u*)(XBg + (ptrdiff_t)(hrow + 64 * i) * 6144 + hoff) : (v4u){0u, 0u, 0u, 0u}; }
#pragma unroll
    for (int i = 0; i < 4; ++i) { pfb[i] = *(const GAS v4u*)(XCg + (size_t)i * (32 * 6144) + boff); pfc[i] = *(const GAS v4u*)(XCg + (size_t)i * (32 * 6144) + 1024 + boff); }
    if (w == 0) { pd0 = *(const GAS float*)(DTg + doff); pd1 = *(const GAS float*)(DTg + 128 + doff); }

#define SSD_SCAN(ARRP) do { if (w == 0) { LAS float* arr_ = (ARRP); const float a0 = pd0 * a2, a1 = pd1 * a2; float x = a0 + a1; \
            _Pragma("unroll") for (int o = 1; o < 64; o <<= 1) { const float v = __shfl_up(x, o); if (lane >= o) x += v; } \
            arr_[2 * lane] = x - a1; arr_[2 * lane + 1] = x; arr_[128 + 2 * lane] = pd0; arr_[128 + 2 * lane + 1] = pd1; \
            const float E_ = __shfl(x, lane | 15); arr_[256 + 2 * lane] = ex2(E_ - (x - a1)) * pd0; arr_[256 + 2 * lane + 1] = ex2(E_ - x) * pd1; } } while (0)
    SSD_SCAN((LAS float*)(F.lds + L_ARR));
    for (int ck = 0; ck < 64; ++ck) {
        const int t0 = ck * 128;
        LAS float* arr = (LAS float*)(F.lds + L_ARR + (ck & 1) * 1536);
        __syncthreads();
#pragma unroll
        for (int q4 = 0; q4 < 4; ++q4) { v2u o; o.x = pg8::cvt_pk_bf16(st[4 * q4], st[4 * q4 + 1]); o.y = pg8::cvt_pk_bf16(st[4 * q4 + 2], st[4 * q4 + 3]);
            *(LAS v2u*)(ST + (32 * pt + r32) * BS_ + (32 * nt + 8 * q4 + 4 * hh) * 2) = o; }
        {
            const float aL = arr[127];
#pragma unroll
            for (int i = 0; i < 2; ++i) { *(LAS v4u*)(XST + xdst + 64 * i * XS_) = pfx[i]; if (lane < 24) *(LAS v4u*)(HAL + (3 * i + (lane >> 3)) * XS_ + 16 * (lane & 7)) = pfh[i]; }
            v4u rw[2][4];
#pragma unroll
            for (int i = 0; i < 2; ++i)
#pragma unroll
                for (int k = 0; k < 4; ++k) { const int lr = (lane >> 3) + k - 3;
                    LAS unsigned char* src = lr >= 0 ? XST + (8 * w + lr + 64 * i) * XS_ + 16 * (lane & 7) : HAL + (3 * i + 3 + lr) * XS_ + 16 * (lane & 7);
                    rw[i][k] = *(LAS v4u*)src; }
            f32x4 cwa[5], cwb[5];
#pragma unroll
            for (int k = 0; k < 5; ++k) { cwa[k] = *(LAS f32x4*)(CWL + 64 * k + 8 * (lane & 7)); cwb[k] = *(LAS f32x4*)(CWL + 64 * k + 8 * (lane & 7) + 4); }
            asm volatile("s_waitcnt lgkmcnt(0)" ::: "memory");
#pragma unroll
            for (int i = 0; i < 2; ++i) {
                const int row = (tid >> 3) + 64 * i;
                float y[8];
#pragma unroll
                for (int e = 0; e < 8; ++e) y[e] = e < 4 ? cwa[4][e] : cwb[4][e - 4];
#pragma unroll
                for (int k = 0; k < 4; ++k) { const v4u r = rw[i][k];
                    y[0] += cwa[k][0] * bflo(r.x); y[1] += cwa[k][1] * bfhi(r.x); y[2] += cwa[k][2] * bflo(r.y); y[3] += cwa[k][3] * bfhi(r.y);
                    y[4] += cwb[k][0] * bflo(r.z); y[5] += cwb[k][1] * bfhi(r.z); y[6] += cwb[k][2] * bflo(r.w); y[7] += cwb[k][3] * bfhi(r.w); }
#pragma unroll
                for (int e = 0; e < 8; ++e) y[e] = silu_f(y[e]);
                *(LAS bf16x8*)(XT + xdst + 64 * i * XS_) = packf8(y[0], y[1], y[2], y[3], y[4], y[5], y[6], y[7]);
                const float te = ex2(aL - arr[row]) * arr[128 + row];
                *(LAS bf16x8*)(XST + xdst + 64 * i * XS_) = packf8(y[0] * te, y[1] * te, y[2] * te, y[3] * te, y[4] * te, y[5] * te, y[6] * te, y[7] * te);
            }
#pragma unroll
            for (int i = 0; i < 4; ++i) { *(LAS v4u*)(BT + bdst + 32 * i * BS_) = pfb[i]; *(LAS v4u*)(CT + bdst + 32 * i * BS_) = pfc[i]; }
        }
        v2u zw[4];
        { const GAS unsigned char* zb = Zg + (size_t)t0 * 4096;
#pragma unroll
          for (int q4 = 0; q4 < 4; ++q4) zw[q4] = *(const GAS v2u*)(zb + 16 * q4 + zoff); }
        if (ck < 63) {
            const GAS unsigned char* xb = XCg + (size_t)(t0 + 128) * 6144; const GAS unsigned char* rb = XBg + (size_t)(t0 + 128) * 6144;
#pragma unroll
            for (int i = 0; i < 2; ++i) { pfx[i] = *(const GAS v4u*)(rb + (size_t)i * (64 * 6144) + xoff);
                if (lane < 24) pfh[i] = *(const GAS v4u*)(rb + (ptrdiff_t)(hrow + 64 * i) * 6144 + hoff); }
#pragma unroll
            for (int i = 0; i < 4; ++i) { pfb[i] = *(const GAS v4u*)(xb + (size_t)i * (32 * 6144) + boff); pfc[i] = *(const GAS v4u*)(xb + (size_t)i * (32 * 6144) + 1024 + boff); }
            if (w == 0) { const GAS unsigned char* db = DTg + (size_t)(t0 + 128) * 128; pd0 = *(const GAS float*)(db + doff); pd1 = *(const GAS float*)(db + 128 + doff); }
        }
        __syncthreads();
        const float acs_l = arr[lcol];
        int r32o = r32; asm volatile("" : "+v"(r32o));
        bf16x8 cf[8], af[8];
#pragma unroll
        for (int s = 0; s < 8; ++s) { cf[s] = *(LAS bf16x8*)(CT + lcol * BS_ + (16 * s + 8 * hh) * 2); af[s] = *(LAS bf16x8*)(ST + (32 * pt + r32) * BS_ + (16 * s + 8 * hh) * 2); }
        __builtin_amdgcn_sched_barrier(0);
        f32x16 Y;
#pragma unroll
        for (int i = 0; i < 16; ++i) Y[i] = 0.f;
#pragma unroll
        for (int s = 0; s < 8; ++s) Y = MFMA32(af[s], cf[s], Y);
        { const float el = ex2(acs_l);
#pragma unroll
          for (int i = 0; i < 16; ++i) Y[i] *= el; }
#pragma unroll 1
        for (int sti = 0; sti <= lt; ++sti) {
            {
                bf16x8 bfA[8]; f32x4 as4[4], dt4[4]; s16x4 xlo[2], xhi[2];
#pragma unroll
                for (int s = 0; s < 8; ++s) bfA[s] = *(LAS bf16x8*)(BT + (32 * sti + r32) * BS_ + (16 * s + 8 * hh) * 2);
                __builtin_amdgcn_sched_barrier(0);
                f32x16 Gt;
#pragma unroll
                for (int i = 0; i < 16; ++i) Gt[i] = 0.f;
#pragma unroll
                for (int s = 0; s < 8; ++s) Gt = MFMA32(bfA[s], cf[s], Gt);
#pragma unroll
                for (int s2 = 0; s2 < 2; ++s2) { LAS unsigned char* xa = XT + (32 * sti + 16 * s2 + 4 * hh + qq) * XS_ + (32 * pt + 16 * cb16 + 4 * pp) * 2; xlo[s2] = trr(xa); xhi[s2] = trr(xa + 8 * XS_); }
                if (sti < lt) {
                    const float fl = ex2(acs_l - arr[32 * sti + 31]);
#pragma unroll
                    for (int q4 = 0; q4 < 4; ++q4) { as4[q4] = *(LAS f32x4*)(arr + 256 + 32 * sti + 8 * q4 + 4 * hh);
#pragma unroll
                        for (int e = 0; e < 4; ++e) Gt[4 * q4 + e] = Gt[4 * q4 + e] * as4[q4][e] * fl; }
                } else {
#pragma unroll
                    for (int q4 = 0; q4 < 4; ++q4) { const int s0 = 32 * sti + 8 * q4 + 4 * hh; as4[q4] = *(LAS f32x4*)(arr + s0); dt4[q4] = *(LAS f32x4*)(arr + 128 + s0); }
#pragma unroll
                    for (int q4 = 0; q4 < 4; ++q4) {
#pragma unroll
                        for (int e = 0; e < 4; ++e) { float wv = Gt[4 * q4 + e] * ex2(fminf(acs_l - as4[q4][e], 0.f)) * dt4[q4][e]; if ((8 * q4 + 4 * hh + e) > r32o) wv = 0.f; Gt[4 * q4 + e] = wv; }
                    }
                }
#pragma unroll
                for (int s2 = 0; s2 < 2; ++s2) {
                    const bf16x8 wf = packf8(Gt[8 * s2], Gt[8 * s2 + 1], Gt[8 * s2 + 2], Gt[8 * s2 + 3], Gt[8 * s2 + 4], Gt[8 * s2 + 5], Gt[8 * s2 + 6], Gt[8 * s2 + 7]);
                    Y = MFMA32(cat8(xlo[s2], xhi[s2]), wf, Y);
                }
                __builtin_amdgcn_sched_barrier(0);
            }
        }
        {
            GAS unsigned char* yb = YGg + (size_t)t0 * 4096;
            float ssq = 0.f;
#pragma unroll
            for (int q4 = 0; q4 < 4; ++q4) {
                const int p0 = 32 * pt + 8 * q4 + 4 * hh;
                const v2u xw = *(LAS v2u*)(XT + lcol * XS_ + p0 * 2);
                const float y0 = (Y[4 * q4 + 0] + Dsk * bflo(xw.x)) * silu_f(bflo(zw[q4].x)), y1 = (Y[4 * q4 + 1] + Dsk * bfhi(xw.x)) * silu_f(bfhi(zw[q4].x));
                const float y2 = (Y[4 * q4 + 2] + Dsk * bflo(xw.y)) * silu_f(bflo(zw[q4].y)), y3 = (Y[4 * q4 + 3] + Dsk * bfhi(xw.y)) * silu_f(bfhi(zw[q4].y));
                ssq += (y0 * y0 + y1 * y1) + (y2 * y2 + y3 * y3);
                v2u o; o.x = pg8::cvt_pk_bf16(y0, y1); o.y = pg8::cvt_pk_bf16(y2, y3);
                *(GAS v2u*)(yb + 16 * q4 + zoff) = o;
            }
            ssq += __shfl_xor(ssq, 32);
            if (hh == 0) *(GAS float*)(SSQg + (size_t)t0 * 256 + soff) = ssq;
        }
        {
            const float eL = ex2(arr[127]);
#pragma unroll
            for (int i = 0; i < 16; ++i) st[i] *= eL;
#pragma unroll
            for (int kg = 0; kg < 2; ++kg) {
                s16x4 alo[4], ahi[4], blo[4], bhi[4];
#pragma unroll
                for (int k4 = 0; k4 < 4; ++k4) { const int ks = 4 * kg + k4;
                    LAS unsigned char* ba = BT + (16 * ks + 8 * hh + qq) * BS_ + (32 * nt + 16 * cb16 + 4 * pp) * 2;
                    LAS unsigned char* xa = XST + (16 * ks + 8 * hh + qq) * XS_ + (32 * pt + 16 * cb16 + 4 * pp) * 2;
                    alo[k4] = trr(ba); ahi[k4] = trr(ba + 4 * BS_); blo[k4] = trr(xa); bhi[k4] = trr(xa + 4 * XS_); }
                __builtin_amdgcn_sched_barrier(0);
#pragma unroll
                for (int k4 = 0; k4 < 4; ++k4) st = MFMA32(cat8(alo[k4], ahi[k4]), cat8(blo[k4], bhi[k4]), st);
            }
        }
        if (ck < 63) SSD_SCAN((LAS float*)(F.lds + L_ARR + ((ck + 1) & 1) * 1536));
    }
#undef SSD_SCAN
    {
        float* so = A.out + O_SSMP + ((size_t)(b * 32 + hd) * 64 + 32 * pt + r32) * 128 + 32 * nt + 4 * hh;
#pragma unroll
        for (int q4 = 0; q4 < 4; ++q4) *(GAS f32x4*)(so + 8 * q4) = (f32x4){st[4 * q4], st[4 * q4 + 1], st[4 * q4 + 2], st[4 * q4 + 3]};
    }
    __syncthreads();
}

constexpr int KS_ = 144, L_AK = 0, L_AV = 384 * KS_;
static_assert(2 * 384 * KS_ <= RING_BYTES, "attention LDS map");
struct AttnU { size_t tokbase; int dil, k0, colq, g, h; };
__device__ __forceinline__ AttnU attn_unit_decode(int u) {
    AttnU r; const int g = u >> 11, r1 = u & 2047, b = r1 >> 8, r2 = r1 & 255, h = r2 >> 5, blk = r2 & 31;
    const int dsh = 2 * g, res = blk >> (5 - dsh), qb = blk & ((32 >> dsh) - 1);
    r.dil = 1 << dsh; r.tokbase = (size_t)b * SEQ_T + res; r.k0 = 256 * qb - 128; r.colq = (g * 8 + h) * 64; r.g = g; r.h = h; return r;
}
__device__ __forceinline__ void attn_prefetch(const AttnU& U, bool cont, const bf16* Kb, const bf16* Vb, const bf16* Qb, int tid, int wave, int lane, v4u (&pk)[6], v4u (&pv)[6], bf16x8 (&qn)[4]) {
    const int r0 = cont ? 128 : 0, nch = cont ? 4 : 6;
#pragma unroll
    for (int i = 0; i < 6; ++i) { const int ci = tid + 512 * i, row = r0 + (ci >> 3), c8 = ci & 7, key = U.k0 + row;
        if (i >= nch) { pk[i] = (v4u){0u, 0u, 0u, 0u}; pv[i] = pk[i]; }
        else if (key >= 0) { const size_t o = (U.tokbase + (size_t)U.dil * key) * AW + U.colq + 8 * c8; pk[i] = *(const GAS v4u*)(Kb + o); pv[i] = *(const GAS v4u*)(Vb + o); }
        else { pk[i] = (v4u){0u, 0u, 0u, 0u}; pv[i] = pk[i]; } }
    const bf16* qrow = Qb + (U.tokbase + (size_t)U.dil * (U.k0 + 128 + 32 * wave + (lane & 31))) * AW + U.colq + 8 * (lane >> 5);
#pragma unroll
    for (int s = 0; s < 4; ++s) qn[s] = *(const GAS bf16x8*)(qrow + 16 * s);
}
__device__ __forceinline__ void attn_prompt_phase(const Frame& F, const Args& A) {
    unsigned char* ws = A.ws;
    const int lane = fresh_lane(), w = F.wave, tid = fresh_tid(), r32 = lane & 31, hh = lane >> 5;
    const int qq = (lane & 15) >> 2, pp = lane & 3, cb16 = (lane >> 4) & 1;
    const bf16* Qb = (const bf16*)(ws + WS_Q); const bf16* Kb = (const bf16*)(ws + WS_K); const bf16* Vb = (const bf16*)(ws + WS_V);
    constexpr int NU = 3 * 8 * 8 * 32;
    const int per = (NU + F.G - 1) / F.G, lo = blockIdx.x * per, hi = (lo + per < NU) ? lo + per : NU;
    if (lo >= hi) return;
    LAS unsigned char* AK = F.lds + L_AK; LAS unsigned char* AV = F.lds + L_AV;
    v4u pk[6], pv[6]; bf16x8 qn[4];
    AttnU U = attn_unit_decode(lo);
    attn_prefetch(U, false, Kb, Vb, Qb, tid, w, lane, pk, pv, qn);
    int rot = 0; bool cont = false;
    for (int u = lo; u < hi; ++u) {
        __syncthreads();
        rot = cont ? (rot + 8 >= 12 ? rot - 4 : rot + 8) : 0;
        { const int r0 = cont ? 128 : 0, nch = cont ? 4 : 6;
#pragma unroll
          for (int i = 0; i < 6; ++i) if (i < nch) { const int ci = tid + 512 * i, rl = r0 + (ci >> 3), c8 = ci & 7; int sl = rot + (rl >> 5); sl = sl >= 12 ? sl - 12 : sl;
              const int row = sl * 32 + (rl & 31); *(LAS v4u*)(AK + row * KS_ + 16 * c8) = pk[i]; *(LAS v4u*)(AV + row * KS_ + 16 * c8) = pv[i]; } }
        bf16x8 qf[4];
#pragma unroll
        for (int s = 0; s < 4; ++s) qf[s] = qn[s];
        const AttnU C = U;
        if (u + 1 < hi) { U = attn_unit_decode(u + 1);
            cont = (((u + 1) >> 5) == (u >> 5)) && (U.tokbase == C.tokbase) && (U.k0 == C.k0 + 256);
            attn_prefetch(U, cont, Kb, Vb, Qb, tid, w, lane, pk, pv, qn); }
        __syncthreads();
        int r32o = r32; asm volatile("" : "+v"(r32o));
        const int tfirst = (C.k0 < 0) ? 4 - w : 0;
        float m = -INFINITY;
#pragma unroll
        for (int kt = 0; kt < 5; ++kt) {
            if (kt >= tfirst) {
                f32x16 S;
#pragma unroll
                for (int i = 0; i < 16; ++i) S[i] = 0.f;
                int sl = rot + w + kt; sl = sl >= 12 ? sl - 12 : sl;
                LAS unsigned char* kp = AK + (32 * sl + r32) * KS_ + 16 * hh;
                bf16x8 kf[4];
#pragma unroll
                for (int s = 0; s < 4; ++s) kf[s] = *(LAS bf16x8*)(kp + 32 * s);
                __builtin_amdgcn_sched_barrier(0);
#pragma unroll
                for (int s = 0; s < 4; ++s) S = MFMA32(kf[s], qf[s], S);
#pragma unroll
                for (int rr = 0; rr < 16; ++rr) { const int keyrow = (rr & 3) + 8 * (rr >> 2) + 4 * hh; float v = S[rr]; if (kt == 0 && keyrow < r32o) v = -INFINITY; if (kt == 4 && keyrow > r32o) v = -INFINITY; m = fmaxf(m, v); }
            }
        }
        m = fmaxf(m, __shfl_xor(m, 32));
        float lsum = 0.f;
        f32x16 O0, O1;
#pragma unroll
        for (int i = 0; i < 16; ++i) { O0[i] = 0.f; O1[i] = 0.f; }
#pragma unroll
        for (int kt = 0; kt < 5; ++kt) {
            if (kt >= tfirst) {
                f32x16 S;
#pragma unroll
                for (int i = 0; i < 16; ++i) S[i] = 0.f;
                int sl = rot + w + kt; sl = sl >= 12 ? sl - 12 : sl;
                LAS unsigned char* kp = AK + (32 * sl + r32) * KS_ + 16 * hh;
                bf16x8 kf[4]; s16x4 vlo0[2], vhi0[2], vlo1[2], vhi1[2];
#pragma unroll
                for (int s = 0; s < 4; ++s) kf[s] = *(LAS bf16x8*)(kp + 32 * s);
#pragma unroll
                for (int s2 = 0; s2 < 2; ++s2) { LAS unsigned char* va = AV + (32 * sl + 16 * s2 + 4 * hh + qq) * KS_ + (16 * cb16 + 4 * pp) * 2;
                    vlo0[s2] = trr(va); vhi0[s2] = trr(va + 8 * KS_); vlo1[s2] = trr(va + 64); vhi1[s2] = trr(va + 8 * KS_ + 64); }
                __builtin_amdgcn_sched_barrier(0);
#pragma unroll
                for (int s = 0; s < 4; ++s) S = MFMA32(kf[s], qf[s], S);
#pragma unroll
                for (int rr = 0; rr < 16; ++rr) { const int keyrow = (rr & 3) + 8 * (rr >> 2) + 4 * hh; float p = ex2(S[rr] - m); if (kt == 0 && keyrow < r32o) p = 0.f; if (kt == 4 && keyrow > r32o) p = 0.f; S[rr] = p; lsum += p; }
#pragma unroll
                for (int s2 = 0; s2 < 2; ++s2) {
                    const bf16x8 pf = packf8(S[8 * s2], S[8 * s2 + 1], S[8 * s2 + 2], S[8 * s2 + 3], S[8 * s2 + 4], S[8 * s2 + 5], S[8 * s2 + 6], S[8 * s2 + 7]);
                    O0 = MFMA32(cat8(vlo0[s2], vhi0[s2]), pf, O0);
                    O1 = MFMA32(cat8(vlo1[s2], vhi1[s2]), pf, O1);
                }
            }
        }
        lsum += __shfl_xor(lsum, 32);
        const float inv = 1.0f / lsum;
        const size_t orow = C.tokbase + (size_t)C.dil * (C.k0 + 128 + 32 * w + r32);
        bf16* op = (bf16*)(ws + WS_AOG) + (size_t)C.g * AOG_STRIDE + orow * 512 + C.h * 64 + 4 * hh;
#pragma unroll
        for (int q4 = 0; q4 < 4; ++q4) {
            v2u o; o.x = pg8::cvt_pk_bf16(O0[4 * q4] * inv, O0[4 * q4 + 1] * inv); o.y = pg8::cvt_pk_bf16(O0[4 * q4 + 2] * inv, O0[4 * q4 + 3] * inv);
            *(GAS v2u*)(op + 8 * q4) = o;
            v2u o2; o2.x = pg8::cvt_pk_bf16(O1[4 * q4] * inv, O1[4 * q4 + 1] * inv); o2.y = pg8::cvt_pk_bf16(O1[4 * q4 + 2] * inv, O1[4 * q4 + 3] * inv);
            *(GAS v2u*)(op + 32 + 8 * q4) = o2;
        }
        if (hh == 0) ((float*)(ws + WS_LSE))[(size_t)C.g * LSE_STRIDE + orow * 8 + C.h] = m + __builtin_amdgcn_logf(lsum);
    }
    __syncthreads();
}

__device__ __forceinline__ void attn_sample_item(const Frame& F, const Args& A, int it) {
    unsigned char* ws = A.ws;
    const int lane = fresh_lane(), kq = lane >> 2, part = lane & 3;
    const int b = it / 24, hq = it % 24, g = hq >> 3, h = hq & 7;
    const int W = 128 << (2 * g), dil = 1 << (2 * g);
    const float* cache = A.in[2 + g];
    const size_t row = (size_t)P_ROWS + b;
    const bf16* qrow = (const bf16*)(ws + WS_Q) + row * AW + hq * 64 + 32 * (part & 1);
    const bf16* krow = (const bf16*)(ws + WS_K) + row * AW + hq * 64 + 32 * (part & 1);
    const bf16* vrow = (const bf16*)(ws + WS_V) + row * AW + hq * 64;
    float qn[16]; float snew = 0.f;
#pragma unroll
    for (int c = 0; c < 4; ++c) {
        const v4u qw = *(const GAS v4u*)(qrow + 8 * c), kw = *(const GAS v4u*)(krow + 8 * c);
        const bool od = part >= 2;
        qn[4 * c + 0] = od ? bfhi(qw.x) : bflo(qw.x); qn[4 * c + 1] = od ? bfhi(qw.y) : bflo(qw.y); qn[4 * c + 2] = od ? bfhi(qw.z) : bflo(qw.z); qn[4 * c + 3] = od ? bfhi(qw.w) : bflo(qw.w);
        snew += qn[4 * c + 0] * (od ? bfhi(kw.x) : bflo(kw.x)) + qn[4 * c + 1] * (od ? bfhi(kw.y) : bflo(kw.y)) + qn[4 * c + 2] * (od ? bfhi(kw.z) : bflo(kw.z)) + qn[4 * c + 3] * (od ? bfhi(kw.w) : bflo(kw.w));
    }
    snew += __shfl_xor(snew, 1); snew += __shfl_xor(snew, 2);
    const float* kbase = cache + ((size_t)b * W * 2 + 0) * 512 + h * 64 + 16 * part;
    float sc[8];
#pragma unroll
    for (int jj = 0; jj < 8; ++jj) {
        const float* kr = kbase + (size_t)(W - dil * (kq + 16 * jj + 1)) * 1024;
        float acc = 0.f;
#pragma unroll
        for (int i = 0; i < 4; ++i) { const f32x4 kv = *(const GAS f32x4*)(kr + 4 * i); acc += (qn[4 * i] * kv[0] + qn[4 * i + 1] * kv[1]) + (qn[4 * i + 2] * kv[2] + qn[4 * i + 3] * kv[3]); }
        sc[jj] = acc;
    }
#pragma unroll
    for (int jj = 0; jj < 8; ++jj) { sc[jj] += __shfl_xor(sc[jj], 1); sc[jj] += __shfl_xor(sc[jj], 2); }
    float m = snew;
#pragma unroll
    for (int jj = 0; jj < 8; ++jj) m = fmaxf(m, sc[jj]);
#pragma unroll
    for (int o = 4; o < 64; o <<= 1) m = fmaxf(m, __shfl_xor(m, o));
    float lpart = 0.f;
#pragma unroll
    for (int jj = 0; jj < 8; ++jj) { sc[jj] = ex2(sc[jj] - m); lpart += sc[jj]; }
    const float pn = ex2(snew - m);
    const float lsum = wave_sum(lpart) * 0.25f + pn;
    const float* vbase = cache + ((size_t)b * W * 2 + 1) * 512 + h * 64 + lane;
    float o = pn * bflo((unsigned)vrow[lane]);
#pragma unroll
    for (int j2 = 0; j2 < 4; ++j2) {
        float vv[32];
#pragma unroll
        for (int kk = 0; kk < 32; ++kk) vv[kk] = vbase[(size_t)(W - dil * (kk + 32 * j2 + 1)) * 1024];
#pragma unroll
        for (int kk = 0; kk < 32; ++kk) o += __shfl(sc[2 * j2 + (kk >> 4)], 4 * (kk & 15)) * vv[kk];
    }
    o *= 1.0f / lsum;
    ((bf16*)(ws + WS_AOG))[(size_t)g * AOG_STRIDE + row * 512 + h * 64 + lane] = (bf16)f2bf(o);
    if (lane == 0) ((float*)(ws + WS_LSE))[(size_t)g * LSE_STRIDE + row * 8 + h] = m + __builtin_amdgcn_logf(lsum);
}

__device__ __forceinline__ float conv1(const float* sc, const bf16* nw, const float* cwp, const float* cbp, int c) {
    return silu_f(cbp[c] + cwp[c] * sc[c] + cwp[3072 + c] * sc[3072 + c] + cwp[2 * 3072 + c] * sc[2 * 3072 + c] + cwp[3 * 3072 + c] * bflo((unsigned)nw[c]));
}
__device__ __forceinline__ void ssd_sample_item(const Frame& F, const Args& A, int it) {
    unsigned char* ws = A.ws;
    const int lane = fresh_lane(), r32 = lane & 31, hh = lane >> 5;
    const int b = it >> 5, hd = it & 31, g = hd >> 3;
    const float* sc = A.in[5] + (size_t)b * 3 * 3072;
    const bf16* nw = (const bf16*)(ws + WS_XBC) + ((size_t)P_ROWS + b) * 3072;
    const float* cwp = A.in[15]; const float* cbp = A.in[16];
    const float xv = conv1(sc, nw, cwp, cbp, hd * 64 + lane);
    float Bv[4], Cv[4];
#pragma unroll
    for (int e = 0; e < 4; ++e) { Bv[e] = conv1(sc, nw, cwp, cbp, 2048 + g * 128 + 4 * r32 + e); Cv[e] = conv1(sc, nw, cwp, cbp, 2560 + g * 128 + 4 * r32 + e); }
    const size_t row = (size_t)P_ROWS + b;
    const float dt = ((const float*)(ws + WS_DT))[row * 32 + hd];
    const float dA = ex2(dt * (-ex2(A.in[18][hd] * LOG2E)) * LOG2E);
    const float Dsk = A.in[19][hd];
    const float* sin_ = A.in[6] + ((size_t)(b * 32 + hd) * 64) * 128 + 4 * r32;
    float* sout = A.out + O_SSMS + ((size_t)(b * 32 + hd) * 64) * 128 + 4 * r32;
    float yp[32];
#pragma unroll
    for (int i8 = 0; i8 < 2; ++i8) {
        f32x4 sv[16];
#pragma unroll
        for (int k = 0; k < 16; ++k) sv[k] = *(const GAS f32x4*)(sin_ + (size_t)(2 * (16 * i8 + k) + hh) * 128);
#pragma unroll
        for (int k = 0; k < 16; ++k) { const int i = 16 * i8 + k, p = 2 * i + hh;
            const float dx = dt * __shfl(xv, p);
            f32x4 sn; sn[0] = dA * sv[k][0] + dx * Bv[0]; sn[1] = dA * sv[k][1] + dx * Bv[1]; sn[2] = dA * sv[k][2] + dx * Bv[2]; sn[3] = dA * sv[k][3] + dx * Bv[3];
            *(GAS f32x4*)(sout + (size_t)p * 128) = sn;
            yp[i] = (Cv[0] * sn[0] + Cv[1] * sn[1]) + (Cv[2] * sn[2] + Cv[3] * sn[3]); }
    }
#pragma unroll
    for (int d = 16; d >= 1; d >>= 1) {
        const bool up = (r32 & d) != 0;
#pragma unroll
        for (int i = 0; i < d; ++i) { const float give = up ? yp[i] : yp[i + d], keep = up ? yp[i + d] : yp[i]; yp[i] = keep + __shfl_xor(give, d); }
    }
    const float ykeep = yp[0];
    const int pl = 2 * r32 + hh;
    const float xl = __shfl(xv, pl);
    const float z = bflo((unsigned)((const bf16*)(ws + WS_Z))[row * 2048 + hd * 64 + pl]);
    const float yg = (ykeep + Dsk * xl) * silu_f(z);
    ((bf16*)(ws + WS_YG))[row * 2048 + hd * 64 + pl] = (bf16)f2bf(yg);
    const float ssq = wave_sum(yg * yg);
    if (lane == 0) { float* q = (float*)(ws + WS_SSQ) + row * 64 + hd * 2; q[0] = ssq; q[1] = 0.f; }
}

__device__ __forceinline__ void emit_kv_rows2(const bf16* k0, const bf16* v0, float* d0, const bf16* k1, const bf16* v1, float* d1, int lane) {
    const int hl = lane >> 3, c = lane & 7;
    const v4u a0 = *(const GAS v4u*)(k0 + hl * 64 + 16 * (c & 3)), b0 = *(const GAS v4u*)(k0 + hl * 64 + 16 * (c & 3) + 8), w0 = *(const GAS v4u*)(v0 + 8 * lane);
    const v4u a1 = *(const GAS v4u*)(k1 + hl * 64 + 16 * (c & 3)), b1 = *(const GAS v4u*)(k1 + hl * 64 + 16 * (c & 3) + 8), w1 = *(const GAS v4u*)(v1 + 8 * lane);
#define EMIT_KV(KA_, KB_, VW_, dst) do { f32x4 o0, o1; \
        if (c < 4) { o0 = (f32x4){bflo(KA_.x), bflo(KA_.y), bflo(KA_.z), bflo(KA_.w)}; o1 = (f32x4){bflo(KB_.x), bflo(KB_.y), bflo(KB_.z), bflo(KB_.w)}; } \
        else       { o0 = (f32x4){bfhi(KA_.x), bfhi(KA_.y), bfhi(KA_.z), bfhi(KA_.w)}; o1 = (f32x4){bfhi(KB_.x), bfhi(KB_.y), bfhi(KB_.z), bfhi(KB_.w)}; } \
        float* d = (dst) + hl * 64 + 8 * c; *(GAS f32x4*)d = o0; *(GAS f32x4*)(d + 4) = o1; \
        float* e = (dst) + 512 + 8 * lane; *(GAS f32x4*)e = (f32x4){bflo(VW_.x), bfhi(VW_.x), bflo(VW_.y), bfhi(VW_.y)}; *(GAS f32x4*)(e + 4) = (f32x4){bflo(VW_.z), bfhi(VW_.z), bflo(VW_.w), bfhi(VW_.w)}; } while (0)
    EMIT_KV(a0, b0, w0, d0); EMIT_KV(a1, b1, w1, d1);
#undef EMIT_KV
}
__device__ __forceinline__ void emit_outputs(const Frame& F, const Args& A) {
    unsigned char* ws = A.ws;
    const int gw = blockIdx.x * NWAVES + F.wave, NGW = F.G * NWAVES, lane = fresh_lane();
    const bf16* Kb = (const bf16*)(ws + WS_K); const bf16* Vb = (const bf16*)(ws + WS_V);
    constexpr int NR = 8 * 2688 + 3 * 128;
    for (int r = gw; r < NR; r += 2 * NGW) {
        const bf16* kp[2]; const bf16* vp[2]; float* dp[2];
#pragma unroll
        for (int k = 0; k < 2; ++k) {
            int rr = r + k * NGW; if (rr >= NR) rr = r;
            if (rr < 8 * 2688) { const int b = rr / 2688, q = rr % 2688;
                const int g = q < 128 ? 0 : (q < 640 ? 1 : 2), tw = q - (g == 0 ? 0 : (g == 1 ? 128 : 640)), W = 128 << (2 * g);
                const size_t row = (size_t)b * SEQ_T + (SEQ_T - W) + tw;
                kp[k] = Kb + row * AW + g * 512; vp[k] = Vb + row * AW + g * 512;
                dp[k] = A.out + (g == 0 ? pg8::EpiWin::O_KVP0 : (g == 1 ? pg8::EpiWin::O_KVP1 : pg8::EpiWin::O_KVP2)) + ((size_t)b * W + tw) * 1024;
            } else { const int q = rr - 8 * 2688, g = q >> 7, b = q & 127; const size_t row = (size_t)P_ROWS + b;
                kp[k] = Kb + row * AW + g * 512; vp[k] = Vb + row * AW + g * 512;
                dp[k] = A.out + (g == 0 ? O_KVS0 : (g == 1 ? O_KVS1 : O_KVS2)) + (size_t)b * 1024; }
        }
        emit_kv_rows2(kp[0], vp[0], dp[0], kp[1], vp[1], dp[1], lane);
    }
    const bf16* XB = (const bf16*)(ws + WS_XBC);
    const int gt = blockIdx.x * (NWAVES * 64) + fresh_tid(), NT = F.G * NWAVES * 64;
    for (int e = gt; e < 8 * 3 * 384; e += NT) { const int rr = e / 384, c8 = e % 384, b = rr / 3, k = rr % 3;
        const v4u a = *(const GAS v4u*)(XB + ((size_t)b * SEQ_T + SEQ_T - 3 + k) * 3072 + 8 * c8);
        float* d = A.out + pg8::EpiWin::O_CONVP + (size_t)rr * 3072 + 8 * c8; *(GAS f32x4*)d = (f32x4){bflo(a.x), bfhi(a.x), bflo(a.y), bfhi(a.y)}; *(GAS f32x4*)(d + 4) = (f32x4){bflo(a.z), bfhi(a.z), bflo(a.w), bfhi(a.w)}; }
    for (int e = gt; e < 128 * 384; e += NT) { const int b = e / 384, c8 = e % 384;
        const v4u a = *(const GAS v4u*)(XB + ((size_t)P_ROWS + b) * 3072 + 8 * c8);
        float* d = A.out + O_CONVS + ((size_t)b * 3 + 2) * 3072 + 8 * c8; *(GAS f32x4*)d = (f32x4){bflo(a.x), bfhi(a.x), bflo(a.y), bfhi(a.y)}; *(GAS f32x4*)(d + 4) = (f32x4){bflo(a.z), bfhi(a.z), bflo(a.w), bfhi(a.w)}; }
    for (int e = gt; e < 128 * 2 * 768; e += NT) { const int bb = e / 1536, r = e % 1536, rw = r / 768, c4 = r % 768;
        *(GAS f32x4*)(A.out + O_CONVS + ((size_t)bb * 3 + rw) * 3072 + 4 * c4) = *(const GAS f32x4*)(A.in[5] + ((size_t)bb * 3 + rw + 1) * 3072 + 4 * c4); }
}

__device__ __forceinline__ void mixer_phase_a(const Frame& F, const Args& A) {
    conv_prepass(F, A);
    attn_prompt_phase(F, A);
}
__device__ __forceinline__ void mixer_phase_b(const Frame& F, const Args& A) {
    for (int s = blockIdx.x; s < 256; s += F.G) ssd_stream(F, A, s);
    const int gw = blockIdx.x * NWAVES + F.wave, NGW = F.G * NWAVES;
    for (int it = gw; it < 128 * 24; it += NGW) attn_sample_item(F, A, it);
    for (int it = gw; it < 128 * 32; it += NGW) ssd_sample_item(F, A, it);
    emit_outputs(F, A);
}

__device__ __forceinline__ void combine_phase(const Frame& F, const Args& A) {
    unsigned char* ws = A.ws;
    const int gw = blockIdx.x * NWAVES + F.wave, NGW = F.G * NWAVES, lane = fresh_lane();
    const bf16* AOG = (const bf16*)(ws + WS_AOG); const float* LSE = (const float*)(ws + WS_LSE);
    const int h = lane >> 3;
    for (int m0 = gw; m0 < M_REAL; m0 += 4 * NGW) {
        float l0[4], l1[4], l2[4], sq[4]; v4u a[4], bq[4], c[4];
#pragma unroll
        for (int r = 0; r < 4; ++r) { const int mr = m0 + r * NGW; const size_t m = (size_t)(mr < M_REAL ? mr : m0);
            l0[r] = LSE[m * 8 + h]; l1[r] = LSE[LSE_STRIDE + m * 8 + h]; l2[r] = LSE[2 * LSE_STRIDE + m * 8 + h];
            a[r] = *(const GAS v4u*)(AOG + m * 512 + 8 * lane); bq[r] = *(const GAS v4u*)(AOG + AOG_STRIDE + m * 512 + 8 * lane); c[r] = *(const GAS v4u*)(AOG + 2 * AOG_STRIDE + m * 512 + 8 * lane);
            sq[r] = ((const float*)(ws + WS_SSQ))[m * 64 + lane]; }
#pragma unroll
        for (int r = 0; r < 4; ++r) { const int mr = m0 + r * NGW;
            const float mx = fmaxf(l0[r], fmaxf(l1[r], l2[r]));
            float w0 = ex2(l0[r] - mx), w1 = ex2(l1[r] - mx), w2 = ex2(l2[r] - mx);
            const float inv = 1.0f / (w0 + w1 + w2); w0 *= inv; w1 *= inv; w2 *= inv;
            v4u o;
            o.x = pg8::cvt_pk_bf16(w0 * bflo(a[r].x) + w1 * bflo(bq[r].x) + w2 * bflo(c[r].x), w0 * bfhi(a[r].x) + w1 * bfhi(bq[r].x) + w2 * bfhi(c[r].x));
            o.y = pg8::cvt_pk_bf16(w0 * bflo(a[r].y) + w1 * bflo(bq[r].y) + w2 * bflo(c[r].y), w0 * bfhi(a[r].y) + w1 * bfhi(bq[r].y) + w2 * bfhi(c[r].y));
            o.z = pg8::cvt_pk_bf16(w0 * bflo(a[r].z) + w1 * bflo(bq[r].z) + w2 * bflo(c[r].z), w0 * bfhi(a[r].z) + w1 * bfhi(bq[r].z) + w2 * bfhi(c[r].z));
            o.w = pg8::cvt_pk_bf16(w0 * bflo(a[r].w) + w1 * bflo(bq[r].w) + w2 * bflo(c[r].w), w0 * bfhi(a[r].w) + w1 * bfhi(bq[r].w) + w2 * bfhi(c[r].w));
            const float s = wave_sum(sq[r]);
            if (mr < M_REAL) { *(GAS v4u*)((bf16*)(ws + WS_AO) + (size_t)mr * 512 + 8 * lane) = o;
                if (lane == 0) ((float*)(ws + WS_RSTD))[mr] = 1.0f / sqrtf(s * (1.f / 2048.f) + EPS); }
        }
    }
}

__global__ void __launch_bounds__(NWAVES * 64, 2) fwd(Args args) {
    extern __shared__ __attribute__((aligned(16))) unsigned char lds[];
    Frame F;
    F.lds = (LAS unsigned char*)lds;
    F.MISC = (volatile LAS unsigned*)(F.lds + MISC_OFF);
    F.tid = threadIdx.x; F.lane = F.tid & 63; F.wave = __builtin_amdgcn_readfirstlane(F.tid >> 6);
    F.G = gridDim.x;
    unsigned char* ws = args.ws;
    F.ctl = (gu32*)(ws + WS_CTL);
    for (int u = F.tid; u < (LDS_BYTES - LDSCTL_OFF) / 4; u += NWAVES * 64) ((LAS unsigned*)(F.lds + LDSCTL_OFF))[u] = 0u;
    __syncthreads();
    if (F.tid < 32) ((LAS float*)(F.lds + LDSCTL_OFF))[F.tid] = INV_FREQ[F.tid];
    XcdBarrier bar = xcd_barrier_post((unsigned*)(F.ctl + CW_BAR), F.MISC + 8);
#define GRID_BAR() xcd_barrier(bar)
    const int bx = (int)blockIdx.x;
    int kple; asm volatile("s_mov_b32 %0, 256" : "=s"(kple));

    p0_prologue(F, args);
    GRID_BAR();
#define GEMM_REG(EPI, AOFF, BOFF, NN, KK, ...) do { pg8::Gemm g{(bf16*)(ws + (AOFF)), (bf16*)(ws + (BOFF)), P_ROWS, (NN), (KK), (KK)}; pg8::StaticOrder S; S.init(P_ROWS, (NN), F.G, bx); EPI E{__VA_ARGS__}; \
        pg8::gemm_phase<EPI, pg8::StaticOrder, true, true>(F.lds + RING_OFF, g, S, E); } while (0)
#define GEMM_REGV(EPI, AOFF, BOFF, NN, KK, ...) do { pg8::Gemm g{(bf16*)(ws + (AOFF)), (bf16*)(ws + (BOFF)), P_ROWS, (NN), (KK), (KK)}; pg8::StaticOrder S; S.init(P_ROWS, (NN), F.G, bx, 1); EPI E{__VA_ARGS__}; \
        pg8::gemm_phase<EPI, pg8::StaticOrder, true, true>(F.lds + RING_OFF, g, S, E); } while (0)
#define GEMM_SMP(EPI, AOFF, BOFF, NN, KK, PP_, ...) do { pg8::Gemm g{(bf16*)(ws + (AOFF)), (bf16*)(ws + (BOFF)), M_PAD, (NN), (KK) / (PP_), (KK)}; pg8::SampOrder S; S.init((NN), (PP_), (KK) / (PP_), F.G, bx); EPI E{__VA_ARGS__}; \
        pg8::gemm_phase<EPI, pg8::SampOrder, true, true, true>(F.lds + RING_OFF, g, S, E); } while (0)
    using EpiRB1 = pg8::EpiResBf<true, 1>; using EpiRB2 = pg8::EpiResBf<false, 2>; using EpiRB3 = pg8::EpiResBf<false, 1>;
    float* const HRp = (float*)(ws + WS_HR); float* const SQ2 = (float*)(ws + WS_SQ2);
#define SMP_NORM(SSQ_, CW_) do { sample_norm_phase(F, HRp, (bf16*)(ws + WS_U), (SSQ_)); if (bx < 16) { __threadfence(); __syncthreads(); \
        if (threadIdx.x == 0) __hip_atomic_fetch_add(F.ctl + (CW_), 1u, __ATOMIC_RELEASE, __HIP_MEMORY_SCOPE_AGENT); } } while (0)
#define SMP_WAIT(CW_) do { if (threadIdx.x == 0) { const unsigned need = F.G < 16 ? (unsigned)F.G : 16u; while (__hip_atomic_load(F.ctl + (CW_), __ATOMIC_ACQUIRE, __HIP_MEMORY_SCOPE_AGENT) < need) __builtin_amdgcn_s_sleep(4); } \
        __syncthreads(); } while (0)
    GEMM_REG(pg8::EpiSwiGLU<false>, WS_U, WS_W1A, 5632, 1024, (bf16*)(ws + WS_H1), DFF, nullptr);
    GEMM_SMP(pg8::EpiSwiGLU<false>, WS_U, WS_W1A, 5632, 1024, 1, (bf16*)(ws + WS_H1), DFF, nullptr);
#define PLE_SLICE(L0_, L1_, WG0_) do { if (bx >= (WG0_)) { pg8::Gemm g{(bf16*)(ws + WS_PB), (bf16*)(ws + WS_WPP), M_PAD, 1024, kple, kple}; pg8::RangeOrder S; S.init((L0_), (L1_), F.G - (WG0_), bx - (WG0_)); \
        pg8::EpiStoreBf16 E{(bf16*)(ws + WS_PP), 1024}; pg8::gemm_phase<pg8::EpiStoreBf16, pg8::RangeOrder, true, true>(F.lds + RING_OFF, g, S, E); } } while (0)
    if (F.G > 48) PLE_SLICE(0, 464, 24); else PLE_SLICE(0, 1028, 0);
    GRID_BAR();
    GEMM_REGV(EpiRB1, WS_H1, WS_W2A, 1024, DFF, args.in[0], (bf16*)(ws + WS_U), SQ2);
    GEMM_SMP(pg8::EpiResidAt, WS_H1, WS_W2A, 1024, DFF, 11, HRp, 0.5f);
    GRID_BAR();
    SMP_NORM(SQ2, CW_NRM);
    GEMM_REG(pg8::EpiWin, WS_U, WS_WIN, NV_IN, 1024, ws, args.in[17], SQ2, (LAS const float*)(F.lds + LDSCTL_OFF));
    SMP_WAIT(CW_NRM);
    GEMM_SMP(pg8::EpiWin, WS_U, WS_WIN, NV_IN, 1024, 1, ws, args.in[17], SQ2, (LAS const float*)(F.lds + LDSCTL_OFF));
    if (F.G > 48) PLE_SLICE(464, 880, 48);
    GRID_BAR();
    mixer_phase_a(F, args);
    GRID_BAR();
    mixer_phase_b(F, args);
    GRID_BAR();
    combine_phase(F, args);
    GRID_BAR();
    GEMM_REGV(pg8::EpiOssm, WS_YG, WS_WOS, 1024, 2048, (bf16*)(ws + WS_T1), (bf16*)(ws + WS_GS), (const float*)(ws + WS_RSTD));
    GEMM_SMP(pg8::EpiOssmAt, WS_YG, WS_WOS, 1024, 2048, 8, (float*)(ws + WS_T1S), (bf16*)(ws + WS_GS), (const float*)(ws + WS_RSTD));
    GRID_BAR();
    GEMM_REG(pg8::EpiMerge<false>, WS_AO, WS_WOA, 1024, 512, (const bf16*)(ws + WS_T1), nullptr, (bf16*)(ws + WS_GA), (bf16*)(ws + WS_MG));
    GEMM_SMP(pg8::EpiMerge<true>, WS_AO, WS_WOA, 1024, 512, 1, nullptr, (const float*)(ws + WS_T1S), (bf16*)(ws + WS_GA), (bf16*)(ws + WS_MG));
    GRID_BAR();
    GEMM_REG(EpiRB2, WS_MG, WS_WOUT, 1024, 1024, nullptr, (bf16*)(ws + WS_U), SQ2 + M_PAD);
    GEMM_SMP(pg8::EpiResidAt, WS_MG, WS_WOUT, 1024, 1024, 4, HRp, 1.0f);
    GRID_BAR();
    SMP_NORM(SQ2 + M_PAD, CW_NRM + 1);
    GEMM_REG(pg8::EpiSwiGLU<true>, WS_U, WS_W1B, 5632, 1024, (bf16*)(ws + WS_H1), DFF, SQ2 + M_PAD);
    SMP_WAIT(CW_NRM + 1);
    GEMM_SMP(pg8::EpiSwiGLU<true>, WS_U, WS_W1B, 5632, 1024, 1, (bf16*)(ws + WS_H1), DFF, SQ2 + M_PAD);
    if (F.G > 48) PLE_SLICE(880, 1028, 24);
    GRID_BAR();
    GEMM_REGV(EpiRB3, WS_H1, WS_W2B, 1024, DFF, nullptr, (bf16*)(ws + WS_U), SQ2 + 2 * M_PAD);
    GEMM_SMP(pg8::EpiResidAt, WS_H1, WS_W2B, 1024, DFF, 11, HRp, 0.5f);
    GRID_BAR();
    SMP_NORM(SQ2 + 2 * M_PAD, CW_NRM + 2);
    GEMM_REG(pg8::EpiPle, WS_U, WS_WPG, 1024, 1024, (bf16*)(ws + WS_U), (bf16*)(ws + WS_PP), SQ2 + 2 * M_PAD, (bf16*)(ws + WS_MG));
    SMP_WAIT(CW_NRM + 2);
    GEMM_SMP(pg8::EpiPle, WS_U, WS_WPG, 1024, 1024, 1, (bf16*)(ws + WS_U), (bf16*)(ws + WS_PP), SQ2 + 2 * M_PAD, (bf16*)(ws + WS_MG));
    GRID_BAR();
    { const int gw = bx * NWAVES + F.wave, NGW = F.G * NWAVES;
      for (int m = gw; m < M_REAL; m += 4 * NGW) { const int left = (M_REAL - 1 - m) / NGW + 1;
          final_rows4((const bf16*)(ws + WS_MG), args.in[31], args.out, (size_t)m, (size_t)NGW, left < 4 ? left : 4, fresh_lane()); } }
}

extern "C" void kernel_launch(void* const* d_in, const int* in_sizes, int n_in, void* d_out, int out_size, void* d_ws, size_t ws_size, hipStream_t stream) {
    static int grid = 0;
    if (grid == 0) {
        if (n_in != 32 || ws_size < WS_END) { fprintf(stderr, "kernel_launch: need 32 inputs and >= %zu bytes of workspace; got n_in %d, ws %zu; nothing launched\n", (size_t)WS_END, n_in, ws_size); grid = -1; return; }
        int dev = 0, cus = 0, per_cu = 0;
        if (hipGetDevice(&dev) != hipSuccess || hipDeviceGetAttribute(&cus, hipDeviceAttributeMultiprocessorCount, dev) != hipSuccess) { grid = -1; return; }
        if (hipFuncSetAttribute((const void*)fwd, hipFuncAttributeMaxDynamicSharedMemorySize, LDS_BYTES) != hipSuccess) { fprintf(stderr, "kernel_launch: hipFuncSetAttribute failed\n"); grid = -1; return; }
        if (hipOccupancyMaxActiveBlocksPerMultiprocessor(&per_cu, (const void*)fwd, NWAVES * 64, LDS_BYTES) != hipSuccess || per_cu < 1)
            fprintf(stderr, "kernel_launch: note: occupancy query reports %d workgroups per CU\n", per_cu);
        (void)hipGetLastError();
        grid = cus;
    }
    if (grid < 0) return;
    if (hipMemsetAsync((char*)d_ws + WS_CTL, 0, CTL_ZERO_BYTES, stream) != hipSuccess) return;
    Args a{};
    for (int i = 0; i < 32; ++i) a.in[i] = (const float*)d_in[i];
    a.out = (float*)d_out; a.ws = (unsigned char*)d_ws;
    hipLaunchKernelGGL(fwd, dim3(grid), dim3(NWAVES * 64), LDS_BYTES, stream, a);
    const hipError_t le = hipPeekAtLastError();
    if (le != hipSuccess) fprintf(stderr, "kernel_launch: launch failed: %s\n", hipGetErrorName(le));
}
```

```cpp
#include <hip/hip_runtime.h>
#include <cstdio>
#include <cstdint>

constexpr int P_ROWS = 65536, S_ROWS = 128, M_REAL = P_ROWS + S_ROWS, M_PAD = 257 * 256, SEQ_T = 8192;
constexpr int NWAVES = 8;
constexpr int DM = 1024, DFF = 2816, DPLE = 256, DINNER = 2048, CONVD = 3072, NHEAD_S = 32, NSTATE = 128, AW = 1536, NV_IN = 47 * 256;
constexpr float EPS = 1e-6f;

constexpr size_t MiB = 1u << 20;
constexpr size_t rup(size_t x) { return (x + MiB - 1) / MiB * MiB; }
constexpr size_t WS_CTL = 0, CTL_ZERO_BYTES = 1 * MiB;
constexpr size_t WS_W1A = 1 * MiB;
constexpr size_t WS_W2A = WS_W1A + rup((size_t)5632 * 1024 * 2);
constexpr size_t WS_WIN = WS_W2A + rup((size_t)1024 * 2816 * 2);
constexpr size_t WS_WOS = WS_WIN + rup((size_t)NV_IN * 1024 * 2);
constexpr size_t WS_WOA = WS_WOS + rup((size_t)1024 * 2048 * 2);
constexpr size_t WS_WOUT = WS_WOA + rup((size_t)1024 * 512 * 2);
constexpr size_t WS_W1B = WS_WOUT + rup((size_t)1024 * 1024 * 2);
constexpr size_t WS_W2B = WS_W1B + rup((size_t)5632 * 1024 * 2);
constexpr size_t WS_WPG = WS_W2B + rup((size_t)1024 * 2816 * 2);
constexpr size_t WS_WPP = WS_WPG + rup((size_t)1024 * 1024 * 2);
constexpr size_t WS_CS = WS_WPP + rup((size_t)1024 * 256 * 2);
constexpr size_t WS_U = WS_CS + rup((size_t)8193 * 32 * 8);
constexpr size_t WS_H1 = WS_U + rup((size_t)M_PAD * 1024 * 2);
constexpr size_t WS_HR = WS_H1 + rup((size_t)M_PAD * 2816 * 2);
constexpr size_t WS_PB = WS_HR + rup((size_t)M_PAD * 1024 * 4);
constexpr size_t WS_PP = WS_PB + rup((size_t)M_PAD * 256 * 2);
constexpr size_t WS_Z = WS_PP + rup((size_t)M_PAD * 1024 * 2);
constexpr size_t WS_XBC = WS_Z + rup((size_t)M_PAD * 2048 * 2);
constexpr size_t WS_Q = WS_XBC + rup((size_t)M_PAD * 3072 * 2);
constexpr size_t WS_K = WS_Q + rup((size_t)M_PAD * 1536 * 2);
constexpr size_t WS_V = WS_K + rup((size_t)M_PAD * 1536 * 2);
constexpr size_t WS_GS = WS_V + rup((size_t)M_PAD * 1536 * 2);
constexpr size_t WS_GA = WS_GS + rup((size_t)M_PAD * 1024 * 2);
constexpr size_t WS_DT = WS_GA + rup((size_t)M_PAD * 1024 * 2);
constexpr size_t WS_YG = WS_DT + rup((size_t)M_PAD * 32 * 4);
constexpr size_t WS_SSQ = WS_YG + rup((size_t)M_PAD * 2048 * 2);
constexpr size_t WS_RSTD = WS_SSQ + rup((size_t)M_PAD * 64 * 4);
constexpr size_t WS_AOG = WS_RSTD + rup((size_t)M_PAD * 4);
constexpr size_t AOG_STRIDE = (size_t)M_PAD * 512;
constexpr size_t WS_LSE = WS_AOG + rup(3 * AOG_STRIDE * 2);
constexpr size_t LSE_STRIDE = (size_t)M_PAD * 8;
constexpr size_t WS_AO = WS_LSE + rup(3 * LSE_STRIDE * 4);
constexpr size_t WS_T1 = WS_AO + rup((size_t)M_PAD * 512 * 2);
constexpr size_t WS_MG = WS_T1 + rup((size_t)M_PAD * 1024 * 4);
constexpr size_t WS_QS = WS_MG + rup((size_t)M_PAD * 1024 * 2);
constexpr size_t WS_XC = WS_QS + rup((size_t)128 * 24 * 64 * 4);
constexpr size_t WS_SQ2 = WS_XC + rup((size_t)65536 * 3072 * 2);
constexpr size_t WS_T1S = WS_SQ2 + rup((size_t)3 * M_PAD * 4);
constexpr size_t WS_END = WS_T1S + rup((size_t)256 * 1024 * 4);
constexpr int CW_TMO = 0, CW_CODE = 1, CW_NRM = 64, CW_BAR = 4096;

namespace pg8 {
#define PG8_LAS __attribute__((address_space(3)))
typedef unsigned short bf16_t;
typedef short bf16x8 __attribute__((ext_vector_type(8)));
typedef float f32x4 __attribute__((ext_vector_type(4)));
typedef unsigned u32x4 __attribute__((ext_vector_type(4)));
constexpr int BM = 256, BK = 64, HALF = 128, HTB = HALF * BK * 2  , STAGE_BYTES = 8 * HTB, NXCD = 8, WGM = 8;

__host__ __device__ __forceinline__ int lds_byte(int r, int c) { const int st = (r >> 4) * 2 + (c >> 5), rr = r & 15, cc = c & 31, ob = rr * 64 + cc * 2; return st * 1024 + (ob ^ (((ob >> 9) & 1) << 5)); }
__host__ __device__ __forceinline__ void stage_rc(int b, int& R, int& C) { const int st = b / 1024, sb = b % 1024, swz = sb ^ (((sb >> 9) & 1) << 5); R = (st >> 1) * 16 + swz / 64; C = (st & 1) * 32 + (swz % 64) / 2; }
__host__ __device__ __forceinline__ int perm32(int rho) { const int n = rho >> 4, i = rho & 15; return 8 * (i >> 2) + 4 * n + (i & 3); }

struct Unit { int pm, pn, ko; };
struct Gemm { const bf16_t* A; const bf16_t* Bt; int M, N, K, ld; };

struct StaticOrder {
    int nM, nN, nwg, G, c, rev;
    __host__ __device__ void init(int M, int N, int G_, int c_, int rev_ = 0) { nM = M / BM; nN = N / BM; nwg = nM * nN; G = G_; c = c_; rev = rev_; }
    __host__ __device__ bool next(int i, Unit& u) const {
        const long L = (long)i * G + c; if (L >= nwg) return false;
        int wgid = (int)L; { const int q = nwg / NXCD, r = nwg % NXCD, xcd = wgid % NXCD, off = wgid / NXCD; wgid = (xcd < r ? xcd * (q + 1) : r * (q + 1) + (xcd - r) * q) + off; }
        const int nig = WGM * nN, gid = wgid / nig, fm = gid * WGM, gsz = (nM - fm) < WGM ? (nM - fm) : WGM;
        const int pm = fm + ((wgid % nig) % gsz); u.pm = rev ? nM - 1 - pm : pm; u.pn = (wgid % nig) / gsz; u.ko = 0; return true;
    }
    __device__ __forceinline__ void a_ready(const Unit&) const {}
    __device__ __forceinline__ void done(const Unit&) const {}
};

struct SampOrder {
    int nN, P, Kp, G, c;
    __device__ __forceinline__ void init(int N, int P_, int Kp_, int G_, int c_) { nN = N / BM; P = P_; Kp = Kp_; G = G_; c = c_; }
    __device__ __forceinline__ bool next(int i, Unit& u) const { const long L = (long)i * G + c; if (L >= (long)nN * P) return false;
        int pm = 256; asm volatile("" : "+s"(pm));
        u.pm = pm; u.pn = (int)(L % nN); u.ko = (int)(L / nN) * Kp; return true; }
    __device__ __forceinline__ void a_ready(const Unit&) const {}
    __device__ __forceinline__ void done(const Unit&) const {}
};

struct RangeOrder {
    int L0, L1, G, c;
    __device__ __forceinline__ void init(int L0_, int L1_, int G_, int c_) { L0 = L0_; L1 = L1_; G = G_; c = c_; }
    __device__ __forceinline__ bool next(int i, Unit& u) const { const int L = L0 + i * G + c; if (L >= L1) return false; u.pm = L >> 2; u.pn = L & 3; u.ko = 0; return true; }
    __device__ __forceinline__ void a_ready(const Unit&) const {}
    __device__ __forceinline__ void done(const Unit&) const {}
};

__device__ __forceinline__ unsigned cvt_pk_bf16(float lo, float hi) { unsigned r; asm volatile("v_cvt_pk_bf16_f32 %0, %1, %2" : "=v"(r) : "v"(lo), "v"(hi)); return r; }

constexpr float C2Q = 0.125f * 1.4426950408889634f;
typedef float f32x2e __attribute__((ext_vector_type(2)));
typedef unsigned u32x2e __attribute__((ext_vector_type(2)));

__device__ __forceinline__ float ex2(float x) { return __builtin_amdgcn_exp2f(x); }
__device__ __forceinline__ float sigm(float x) { return __builtin_amdgcn_rcpf(1.0f + ex2(-1.4426950408889634f * x)); }
__device__ __forceinline__ float silu_f(float x) { return x * sigm(x); }
__device__ __forceinline__ float softplus_f(float x) { return x > 20.f ? x : 0.6931471805599453f * __builtin_amdgcn_logf(1.0f + ex2(1.4426950408889634f * x)); }
__device__ __forceinline__ u32x4 pack8(const f32x4 a, const f32x4 b) { u32x4 w; w.x = cvt_pk_bf16(a[0], a[1]); w.y = cvt_pk_bf16(a[2], a[3]); w.z = cvt_pk_bf16(b[0], b[1]); w.w = cvt_pk_bf16(b[2], b[3]); return w; }
__device__ __forceinline__ float bf_lo(unsigned w) { return __builtin_bit_cast(float, w << 16); }
__device__ __forceinline__ float bf_hi(unsigned w) { return __builtin_bit_cast(float, w & 0xffff0000u); }

template <bool RS> struct EpiSwiGLU {
    static constexpr bool PERM = true, AFTER_DRAIN = false;
    bf16_t* O; int ldc; const float* ssq;
    __device__ __forceinline__ void operator()(const f32x4 (&acc)[2][2][4][2], const Unit& u, int wr, int wc, int fr, int fq) const {
        const int row0 = u.pm * BM + wr * 64 + fr, col0 = u.pn * HALF + wc * 32 + 8 * fq;
        float rsv[2][4];
#pragma unroll
        for (int ai = 0; ai < 2; ++ai)
#pragma unroll
            for (int m = 0; m < 4; ++m) rsv[ai][m] = RS ? ssq[row0 + ai * HALF + m * 16] : 0.f;
#pragma unroll
        for (int ai = 0; ai < 2; ++ai)
#pragma unroll
            for (int m = 0; m < 4; ++m) {
                const int row = row0 + ai * HALF + m * 16;
                bf16_t* rowp = O + (size_t)row * ldc + col0;
                const float rs = RS ? __builtin_amdgcn_rsqf(rsv[ai][m] * (1.f / 1024.f) + 1e-6f) : 1.0f;
                f32x4 v0, v1;
#pragma unroll
                for (int j = 0; j < 4; ++j) { v0[j] = silu_f(acc[ai][0][m][0][j] * rs) * (acc[ai][1][m][0][j] * rs); v1[j] = silu_f(acc[ai][0][m][1][j] * rs) * (acc[ai][1][m][1][j] * rs); }
                *(u32x4*)rowp = pack8(v0, v1);
            }
    }
};

template <int MODE, bool NORM> struct EpiResid {
    static constexpr bool PERM = false, AFTER_DRAIN = false;
    const float* R0; const float* R1; float* O; float scale; const bf16_t* PP; const float* ssq_in; bf16_t* HB; float* ssq_out;
    __device__ __forceinline__ void operator()(const f32x4 (&acc)[2][2][4][2], const Unit& u, int wr, int wc, int fr, int fq) const {
        const int col0 = u.pn * BM + wc * 32 + 4 * fq;
        constexpr int MB = MODE == 1 ? 2 : 4;
#pragma unroll
        for (int ab = 0; ab < 8 / MB; ++ab) {
            const int ai = (ab * MB) >> 2, m0 = (ab * MB) & 3;
            f32x4 rv[MB][2][2]; u32x2e pw[MB][2][2]; float rsi[MB];
#pragma unroll
            for (int mm = 0; mm < MB; ++mm) { const int m = mm;
                const int row = u.pm * BM + ai * HALF + wr * 64 + (m0 + mm) * 16 + fr;
                const float* rp = row < P_ROWS ? R0 + (size_t)row * 1024 : R1 + (size_t)(row - P_ROWS) * 1024;
                const bool live = row < M_REAL;
                rsi[m] = MODE == 1 ? ssq_in[row] : 0.f;
#pragma unroll
                for (int bj = 0; bj < 2; ++bj)
#pragma unroll
                    for (int n = 0; n < 2; ++n) { const int c = col0 + bj * HALF + n * 16;
                        rv[m][bj][n] = live ? *(const f32x4*)(rp + c) : (f32x4){0.f, 0.f, 0.f, 0.f};
                        if (MODE == 1) pw[m][bj][n] = *(const u32x2e*)(PP + (size_t)row * 1024 + c); }
            }
#pragma unroll
            for (int mm = 0; mm < MB; ++mm) { const int m = mm;
                const int row = u.pm * BM + ai * HALF + wr * 64 + (m0 + mm) * 16 + fr;
                const float rs1 = MODE == 1 ? __builtin_amdgcn_rsqf(rsi[m] * (1.f / 1024.f) + 1e-6f) : 1.0f;
                float sq = 0.f;
#pragma unroll
                for (int bj = 0; bj < 2; ++bj)
#pragma unroll
                    for (int n = 0; n < 2; ++n) {
                        const int c = col0 + bj * HALF + n * 16;
                        f32x4 r = rv[m][bj][n];
                        const f32x4 a = acc[ai][bj][m0 + mm][n];
                        if (MODE == 0) r = r + a * scale;
                        else { const u32x2e p2 = pw[m][bj][n];
                               r[0] += sigm(a[0] * rs1) * bf_lo(p2.x); r[1] += sigm(a[1] * rs1) * bf_hi(p2.x); r[2] += sigm(a[2] * rs1) * bf_lo(p2.y); r[3] += sigm(a[3] * rs1) * bf_hi(p2.y); }
                        *(f32x4*)(O + (size_t)row * 1024 + c) = r;
                        if (NORM) { u32x2e hw; hw.x = cvt_pk_bf16(r[0], r[1]); hw.y = cvt_pk_bf16(r[2], r[3]); *(u32x2e*)(HB + (size_t)row * 1024 + c) = hw;
                                    sq += (r[0] * r[0] + r[1] * r[1]) + (r[2] * r[2] + r[3] * r[3]); }
                    }
                if (NORM) { sq += __shfl_xor(sq, 16); sq += __shfl_xor(sq, 32);
                            if (fq == 0) __hip_atomic_fetch_add(ssq_out + row, sq, __ATOMIC_RELAXED, __HIP_MEMORY_SCOPE_AGENT); }
            }
        }
    }
};
template <bool SRC_F32, int SCALE2  > struct EpiResBf {
    static constexpr bool PERM = true, AFTER_DRAIN = false;
    const float* R0; bf16_t* HB; float* ssq_out;
    __device__ __forceinline__ void operator()(const f32x4 (&acc)[2][2][4][2], const Unit& u, int wr, int wc, int fr, int fq) const {
        const int row0 = u.pm * BM + wr * 64 + fr, col0 = u.pn * BM + wc * 32 + 8 * fq;
        constexpr float scale = 0.5f * SCALE2;
#pragma unroll
        for (int ai = 0; ai < 2; ++ai) {
            f32x4 rf[4][2][2]; u32x4 rb[4][2];
#pragma unroll
            for (int m = 0; m < 4; ++m)
#pragma unroll
                for (int bj = 0; bj < 2; ++bj) { const size_t o = (size_t)(row0 + ai * HALF + m * 16) * 1024 + col0 + bj * HALF;
                    if constexpr (SRC_F32) { rf[m][bj][0] = *(const f32x4*)(R0 + o); rf[m][bj][1] = *(const f32x4*)(R0 + o + 4); rb[m][bj] = (u32x4){0u, 0u, 0u, 0u}; }
                    else { rb[m][bj] = *(const u32x4*)(HB + o); rf[m][bj][0] = (f32x4){0.f, 0.f, 0.f, 0.f}; rf[m][bj][1] = rf[m][bj][0]; } }
#pragma unroll
            for (int m = 0; m < 4; ++m) {
                const int row = row0 + ai * HALF + m * 16;
                float sq = 0.f;
#pragma unroll
                for (int bj = 0; bj < 2; ++bj) {
                    const size_t o = (size_t)row * 1024 + col0 + bj * HALF;
                    f32x4 r0, r1;
                    if constexpr (SRC_F32) { r0 = rf[m][bj][0]; r1 = rf[m][bj][1]; }
                    else { const u32x4 w = rb[m][bj]; r0 = (f32x4){bf_lo(w.x), bf_hi(w.x), bf_lo(w.y), bf_hi(w.y)}; r1 = (f32x4){bf_lo(w.z), bf_hi(w.z), bf_lo(w.w), bf_hi(w.w)}; }
                    r0 = r0 + acc[ai][bj][m][0] * scale; r1 = r1 + acc[ai][bj][m][1] * scale;
                    *(u32x4*)(HB + o) = pack8(r0, r1);
                    sq += ((r0[0] * r0[0] + r0[1] * r0[1]) + (r0[2] * r0[2] + r0[3] * r0[3])) + ((r1[0] * r1[0] + r1[1] * r1[1]) + (r1[2] * r1[2] + r1[3] * r1[3]));
                }
                sq += __shfl_xor(sq, 16); sq += __shfl_xor(sq, 32);
                if (fq == 0) __hip_atomic_fetch_add(ssq_out + row, sq, __ATOMIC_RELAXED, __HIP_MEMORY_SCOPE_AGENT);
            }
        }
    }
};
struct EpiPle {
    static constexpr bool PERM = true, AFTER_DRAIN = false;
    const bf16_t* HB; const bf16_t* PP; const float* ssq_in; bf16_t* OUT;
    __device__ __forceinline__ void operator()(const f32x4 (&acc)[2][2][4][2], const Unit& u, int wr, int wc, int fr, int fq) const {
        const int row0 = u.pm * BM + wr * 64 + fr, col0 = u.pn * BM + wc * 32 + 8 * fq;
#pragma unroll
        for (int ai = 0; ai < 2; ++ai) {
            u32x4 hv[4][2], pw[4][2]; float rsi[4];
#pragma unroll
            for (int m = 0; m < 4; ++m) { const int row = row0 + ai * HALF + m * 16; rsi[m] = ssq_in[row];
#pragma unroll
                for (int bj = 0; bj < 2; ++bj) { const size_t o = (size_t)row * 1024 + col0 + bj * HALF; hv[m][bj] = *(const u32x4*)(HB + o); pw[m][bj] = *(const u32x4*)(PP + o); } }
#pragma unroll
            for (int m = 0; m < 4; ++m) {
                const int row = row0 + ai * HALF + m * 16;
                const float rs1 = __builtin_amdgcn_rsqf(rsi[m] * (1.f / 1024.f) + 1e-6f);
#pragma unroll
                for (int bj = 0; bj < 2; ++bj) { const f32x4 a0 = acc[ai][bj][m][0], a1 = acc[ai][bj][m][1]; const u32x4 h4 = hv[m][bj], p4 = pw[m][bj];
                    f32x4 r0, r1;
                    r0[0] = bf_lo(h4.x) + sigm(a0[0] * rs1) * bf_lo(p4.x); r0[1] = bf_hi(h4.x) + sigm(a0[1] * rs1) * bf_hi(p4.x); r0[2] = bf_lo(h4.y) + sigm(a0[2] * rs1) * bf_lo(p4.y); r0[3] = bf_hi(h4.y) + sigm(a0[3] * rs1) * bf_hi(p4.y);
                    r1[0] = bf_lo(h4.z) + sigm(a1[0] * rs1) * bf_lo(p4.z); r1[1] = bf_hi(h4.z) + sigm(a1[1] * rs1) * bf_hi(p4.z); r1[2] = bf_lo(h4.w) + sigm(a1[2] * rs1) * bf_lo(p4.w); r1[3] = bf_hi(h4.w) + sigm(a1[3] * rs1) * bf_hi(p4.w);
                    *(u32x4*)(OUT + (size_t)row * 1024 + col0 + bj * HALF) = pack8(r0, r1); }
            }
        }
    }
};
struct EpiResidAt {
    static constexpr bool PERM = false, AFTER_DRAIN = false;
    float* O; float scale;
    __device__ __forceinline__ void operator()(const f32x4 (&acc)[2][2][4][2], const Unit& u, int wr, int wc, int fr, int fq) const {
        const int col0 = u.pn * BM + wc * 32 + 4 * fq;
#pragma unroll
        for (int m = 0; m < 4; ++m) {
            const int row = u.pm * BM + wr * 64 + m * 16 + fr;
#pragma unroll
            for (int bj = 0; bj < 2; ++bj)
#pragma unroll
                for (int n = 0; n < 2; ++n) { float* p = O + (size_t)row * 1024 + col0 + bj * HALF + n * 16; const f32x4 a = acc[0][bj][m][n];
#pragma unroll
                    for (int j = 0; j < 4; ++j) __hip_atomic_fetch_add(p + j, a[j] * scale, __ATOMIC_RELAXED, __HIP_MEMORY_SCOPE_AGENT); }
        }
    }
};

struct EpiStoreBf16 {
    static constexpr bool PERM = true, AFTER_DRAIN = false;
    bf16_t* O; int ldc;
    __device__ __forceinline__ void operator()(const f32x4 (&acc)[2][2][4][2], const Unit& u, int wr, int wc, int fr, int fq) const {
        const int row0 = u.pm * BM + wr * 64 + fr, col0 = u.pn * BM + wc * 32 + 8 * fq;
#pragma unroll
        for (int ai = 0; ai < 2; ++ai)
#pragma unroll
            for (int m = 0; m < 4; ++m) { bf16_t* rowp = O + (size_t)(row0 + ai * HALF + m * 16) * ldc + col0;
#pragma unroll
                for (int bj = 0; bj < 2; ++bj) *(u32x4*)(rowp + bj * HALF) = pack8(acc[ai][bj][m][0], acc[ai][bj][m][1]); }
    }
};

struct EpiOssm {
    static constexpr bool PERM = true, AFTER_DRAIN = false;
    bf16_t* T1; const bf16_t* GS; const float* rstd;
    __device__ __forceinline__ void operator()(const f32x4 (&acc)[2][2][4][2], const Unit& u, int wr, int wc, int fr, int fq) const {
        const int row0 = u.pm * BM + wr * 64 + fr, col0 = u.pn * BM + wc * 32 + 8 * fq;
#pragma unroll
        for (int ai = 0; ai < 2; ++ai) {
            u32x4 gw[4][2]; float rsv[4];
#pragma unroll
            for (int m = 0; m < 4; ++m) { const int row = row0 + ai * HALF + m * 16; rsv[m] = rstd[row];
#pragma unroll
                for (int bj = 0; bj < 2; ++bj) gw[m][bj] = *(const u32x4*)(GS + (size_t)row * 1024 + col0 + bj * HALF); }
#pragma unroll
            for (int m = 0; m < 4; ++m) {
                const int row = row0 + ai * HALF + m * 16; const float rs = rsv[m];
#pragma unroll
                for (int bj = 0; bj < 2; ++bj) {
                    const u32x4 g4 = gw[m][bj]; const f32x4 a0 = acc[ai][bj][m][0], a1 = acc[ai][bj][m][1];
                    f32x4 r0, r1;
                    r0[0] = a0[0] * rs * bf_lo(g4.x); r0[1] = a0[1] * rs * bf_hi(g4.x); r0[2] = a0[2] * rs * bf_lo(g4.y); r0[3] = a0[3] * rs * bf_hi(g4.y);
                    r1[0] = a1[0] * rs * bf_lo(g4.z); r1[1] = a1[1] * rs * bf_hi(g4.z); r1[2] = a1[2] * rs * bf_lo(g4.w); r1[3] = a1[3] * rs * bf_hi(g4.w);
                    *(u32x4*)(T1 + (size_t)row * 1024 + col0 + bj * HALF) = pack8(r0, r1);
                }
            }
        }
    }
};

struct EpiOssmAt {
    static constexpr bool PERM = false, AFTER_DRAIN = false;
    float* T1; const bf16_t* GS; const float* rstd;
    __device__ __forceinline__ void operator()(const f32x4 (&acc)[2][2][4][2], const Unit& u, int wr, int wc, int fr, int fq) const {
        const int col0 = u.pn * BM + wc * 32 + 4 * fq;
#pragma unroll
        for (int m = 0; m < 4; ++m) {
            const int row = u.pm * BM + wr * 64 + m * 16 + fr;
            const float rs = rstd[row];
#pragma unroll
            for (int bj = 0; bj < 2; ++bj)
#pragma unroll
                for (int n = 0; n < 2; ++n) {
                    const int c = col0 + bj * HALF + n * 16;
                    const u32x2e gw = *(const u32x2e*)(GS + (size_t)row * 1024 + c);
                    const f32x4 a = acc[0][bj][m][n]; float* p = T1 + (size_t)(row - P_ROWS) * 1024 + c;
                    __hip_atomic_fetch_add(p + 0, a[0] * rs * bf_lo(gw.x), __ATOMIC_RELAXED, __HIP_MEMORY_SCOPE_AGENT); __hip_atomic_fetch_add(p + 1, a[1] * rs * bf_hi(gw.x), __ATOMIC_RELAXED, __HIP_MEMORY_SCOPE_AGENT);
                    __hip_atomic_fetch_add(p + 2, a[2] * rs * bf_lo(gw.y), __ATOMIC_RELAXED, __HIP_MEMORY_SCOPE_AGENT); __hip_atomic_fetch_add(p + 3, a[3] * rs * bf_hi(gw.y), __ATOMIC_RELAXED, __HIP_MEMORY_SCOPE_AGENT);
                }
        }
    }
};

template <bool SMP> struct EpiMerge {
    static constexpr bool PERM = true, AFTER_DRAIN = false;
    const bf16_t* T1; const float* T1S; const bf16_t* GA; bf16_t* O;
    __device__ __forceinline__ void operator()(const f32x4 (&acc)[2][2][4][2], const Unit& u, int wr, int wc, int fr, int fq) const {
        const int row0 = u.pm * BM + wr * 64 + fr, col0 = u.pn * BM + wc * 32 + 8 * fq;
#pragma unroll
        for (int ab = 0; ab < 4; ++ab) {
            const int ai = ab >> 1, m0 = (ab & 1) * 2;
            u32x4 gw[2][2], tb[2][2]; f32x4 t0[2][2], t1[2][2];
#pragma unroll
            for (int m = 0; m < 2; ++m)
#pragma unroll
                for (int bj = 0; bj < 2; ++bj) { const int row = row0 + ai * HALF + (m0 + m) * 16; const size_t o = (size_t)row * 1024 + col0 + bj * HALF;
                    gw[m][bj] = *(const u32x4*)(GA + o);
                    if constexpr (SMP) { const size_t os = (size_t)(row - P_ROWS) * 1024 + col0 + bj * HALF; t0[m][bj] = *(const f32x4*)(T1S + os); t1[m][bj] = *(const f32x4*)(T1S + os + 4); tb[m][bj] = (u32x4){0u, 0u, 0u, 0u}; }
                    else { tb[m][bj] = *(const u32x4*)(T1 + o); t0[m][bj] = (f32x4){0.f, 0.f, 0.f, 0.f}; t1[m][bj] = t0[m][bj]; } }
#pragma unroll
            for (int m = 0; m < 2; ++m)
#pragma unroll
                for (int bj = 0; bj < 2; ++bj) {
                    const size_t o = (size_t)(row0 + ai * HALF + (m0 + m) * 16) * 1024 + col0 + bj * HALF;
                    const u32x4 g4 = gw[m][bj]; const f32x4 a0 = acc[ai][bj][m0 + m][0], a1 = acc[ai][bj][m0 + m][1];
                    f32x4 x0, x1;
                    if constexpr (SMP) { x0 = t0[m][bj]; x1 = t1[m][bj]; }
                    else { const u32x4 w = tb[m][bj]; x0 = (f32x4){bf_lo(w.x), bf_hi(w.x), bf_lo(w.y), bf_hi(w.y)}; x1 = (f32x4){bf_lo(w.z), bf_hi(w.z), bf_lo(w.w), bf_hi(w.w)}; }
                    f32x4 r0, r1;
                    r0[0] = x0[0] + bf_lo(g4.x) * a0[0]; r0[1] = x0[1] + bf_hi(g4.x) * a0[1]; r0[2] = x0[2] + bf_lo(g4.y) * a0[2]; r0[3] = x0[3] + bf_hi(g4.y) * a0[3];
                    r1[0] = x1[0] + bf_lo(g4.z) * a1[0]; r1[1] = x1[1] + bf_hi(g4.z) * a1[1]; r1[2] = x1[2] + bf_lo(g4.w) * a1[2]; r1[3] = x1[3] + bf_hi(g4.w) * a1[3];
                    *(u32x4*)(O + o) = pack8(r0, r1);
                }
        }
    }
};

struct EpiWin {
    static constexpr bool PERM = true, AFTER_DRAIN = false;
    unsigned char* ws; const float* dtb; const float* ssq; PG8_LAS const float* ifq;
    static constexpr size_t O_KVP0 = 67108864ull + 131072ull, O_KVP1 = O_KVP0 + 1048576ull, O_KVP2 = O_KVP1 + 4194304ull, O_CONVP = O_KVP2 + 16777216ull, O_SSMP = O_CONVP + 73728ull,
                            O_KVS0 = O_SSMP + 2097152ull, O_KVS1 = O_KVS0 + 131072ull, O_KVS2 = O_KVS1 + 131072ull, O_CONVS = O_KVS2 + 131072ull, O_SSMS = O_CONVS + 1179648ull;
    __device__ __forceinline__ void operator()(const f32x4 (&acc)[2][2][4][2], const Unit& u, int wr, int wc, int fr, int fq) const {
        const int pn = u.pn;
        const int cl = wc * 32 + 8 * fq;
        if (pn < 46) {
            size_t boff; int ldc, ct;
            if (pn < 8) { boff = WS_Z; ldc = 2048; ct = pn; } else if (pn < 20) { boff = WS_XBC; ldc = 3072; ct = pn - 8; }
            else if (pn < 26) { boff = WS_Q; ldc = 1536; ct = pn - 20; } else if (pn < 32) { boff = WS_K; ldc = 1536; ct = pn - 26; } else if (pn < 38) { boff = WS_V; ldc = 1536; ct = pn - 32; }
            else if (pn < 42) { boff = WS_GS; ldc = 1024; ct = pn - 38; } else { boff = WS_GA; ldc = 1024; ct = pn - 42; }
            const bool rot = pn >= 20 && pn < 32, sg = pn >= 38;
            const float sc = pn < 26 ? C2Q : 1.0f;
            bf16_t* base = (bf16_t*)(ws + boff) + ct * BM + cl;
            float rsv[2][4];
#pragma unroll
            for (int ai = 0; ai < 2; ++ai)
#pragma unroll
                for (int m = 0; m < 4; ++m) rsv[ai][m] = ssq[u.pm * BM + ai * HALF + wr * 64 + m * 16 + fr];
            f32x4 fr4 = (f32x4){0.f, 0.f, 0.f, 0.f};
            if (rot) fr4 = *(PG8_LAS const f32x4*)(ifq + ((cl & 63) >> 1));
#pragma unroll
            for (int ai = 0; ai < 2; ++ai)
#pragma unroll
                for (int m = 0; m < 4; ++m) {
                    const int row = u.pm * BM + ai * HALF + wr * 64 + m * 16 + fr;
                    const float rs = __builtin_amdgcn_rsqf(rsv[ai][m] * (1.f / 1024.f) + 1e-6f);
                    f32x4 cs0 = (f32x4){1.f, 0.f, 1.f, 0.f}, cs1 = cs0;
                    if (rot) {
                        const float posf = (float)(row < P_ROWS ? (row & (SEQ_T - 1)) : SEQ_T);
                        float cc[4], sn[4];
#pragma unroll
                        for (int e = 0; e < 4; ++e) { const float ang = posf * fr4[e];
                            const float k = __builtin_rintf(ang * 0.15915494309189535f);
                            float r = __builtin_fmaf(-k, 6.2831855f, ang); r = __builtin_fmaf(-k, -1.7484555e-7f, r);
                            const float t = r * 0.15915494309189535f; cc[e] = __builtin_amdgcn_cosf(t); sn[e] = __builtin_amdgcn_sinf(t); }
                        cs0 = (f32x4){cc[0], sn[0], cc[1], sn[1]}; cs1 = (f32x4){cc[2], sn[2], cc[3], sn[3]};
                    }
#pragma unroll
                    for (int bj = 0; bj < 2; ++bj) {
                        f32x4 a0 = acc[ai][bj][m][0] * rs, a1 = acc[ai][bj][m][1] * rs;
                        if (sg) {
#pragma unroll
                            for (int j = 0; j < 4; ++j) { a0[j] = sigm(a0[j]); a1[j] = sigm(a1[j]); } }
                        if (rot) {
                            f32x4 w0, w1;
                            w0[0] = (a0[0] * cs0[0] - a0[1] * cs0[1]) * sc; w0[1] = (a0[1] * cs0[0] + a0[0] * cs0[1]) * sc;
                            w0[2] = (a0[2] * cs0[2] - a0[3] * cs0[3]) * sc; w0[3] = (a0[3] * cs0[2] + a0[2] * cs0[3]) * sc;
                            w1[0] = (a1[0] * cs1[0] - a1[1] * cs1[1]) * sc; w1[1] = (a1[1] * cs1[0] + a1[0] * cs1[1]) * sc;
                            w1[2] = (a1[2] * cs1[2] - a1[3] * cs1[3]) * sc; w1[3] = (a1[3] * cs1[2] + a1[2] * cs1[3]) * sc;
                            a0 = w0; a1 = w1;
                        }
                        *(u32x4*)(base + (size_t)row * ldc + bj * HALF) = pack8(a0, a1);
                    }
                }
        } else {
            if (wc == 0) {
                const int c0 = 8 * fq; float* DT = (float*)(ws + WS_DT);
                const f32x4 b0 = *(const f32x4*)(dtb + c0), b1 = *(const f32x4*)(dtb + c0 + 4);
#pragma unroll
                for (int ai = 0; ai < 2; ++ai)
#pragma unroll
                    for (int m = 0; m < 4; ++m) {
                        const int row = u.pm * BM + ai * HALF + wr * 64 + m * 16 + fr;
                        const float rs = __builtin_amdgcn_rsqf(ssq[row] * (1.f / 1024.f) + 1e-6f);
                        f32x4 a0 = acc[ai][0][m][0] * rs + b0, a1 = acc[ai][0][m][1] * rs + b1;
#pragma unroll
                        for (int j = 0; j < 4; ++j) { a0[j] = softplus_f(a0[j]); a1[j] = softplus_f(a1[j]); }
                        *(f32x4*)(DT + (size_t)row * 32 + c0) = a0; *(f32x4*)(DT + (size_t)row * 32 + c0 + 4) = a1;
                    }
            }
        }
    }
};

template <class Epi, class Sched, bool ALIGN_EPI = false, bool SP2 = false, bool HALFM = false>
__device__ __forceinline__ void gemm_phase(PG8_LAS unsigned char* lds, const Gemm g, const Sched& S, const Epi& E) {
    int tid_ = threadIdx.x; asm volatile("" : "+v"(tid_));
    const int tid = tid_, wid = __builtin_amdgcn_readfirstlane(tid >> 6), lane = tid & 63, wr = wid >> 2, wc = wid & 3, fr = lane & 15, fq = lane >> 4;
    const int K = g.K, nt = K / BK;
    unsigned voffA[2], voffB[2];
#pragma unroll
    for (int i = 0; i < 2; ++i) { int R, C; stage_rc(tid * 16 + i * 8192, R, C); const int Rb = Epi::PERM ? ((R & ~31) + perm32(R & 31)) : R;
        voffA[i] = (unsigned)(R * g.ld + C) * 2u; voffB[i] = (unsigned)(Rb * g.ld + C) * 2u; }
    const size_t kstep = (size_t)(BK * 2);
    const size_t hstep = (size_t)HALF * g.ld * 2;
    const size_t tstep = 2 * hstep;
    const unsigned ldsw = (unsigned)wid * 1024u;
    const int aoff = lds_byte(wr * 64 + fr, fq * 8), boff = lds_byte(wc * 32 + fr, fq * 8);
#define PG8_SA(b, h) (((b) * 2 + (h)) * HTB)
#define PG8_SB(b, h) ((4 + (b) * 2 + (h)) * HTB)
#define PG8_STAGE(bufoff, gbase, voff) do { _Pragma("unroll") for (int _i = 0; _i < 2; ++_i) \
        __builtin_amdgcn_global_load_lds((const unsigned*)((const char*)(gbase) + (voff)[_i]), (PG8_LAS unsigned*)(lds + (bufoff) + ldsw + _i * 8192), 16, 0, 0); } while (0)
#define PG8_LDA(dst, b, h) do { _Pragma("unroll") for (int m = 0; m < 4; ++m) _Pragma("unroll") for (int k = 0; k < 2; ++k) dst[m][k] = *(const PG8_LAS bf16x8*)(lds + PG8_SA(b, h) + aoff + m * 2048 + k * 1024); } while (0)
#define PG8_LDB(dst, b, h) do { _Pragma("unroll") for (int n = 0; n < 2; ++n) _Pragma("unroll") for (int k = 0; k < 2; ++k) dst[n][k] = *(const PG8_LAS bf16x8*)(lds + PG8_SB(b, h) + boff + n * 2048 + k * 1024); } while (0)
#define PG8_MMA(ai, bj, At, Bt) do { __builtin_amdgcn_s_setprio(1); _Pragma("unroll") for (int m = 0; m < 4; ++m) _Pragma("unroll") for (int n = 0; n < 2; ++n) _Pragma("unroll") for (int k = 0; k < 2; ++k) \
        acc[ai][bj][m][n] = __builtin_amdgcn_mfma_f32_16x16x32_bf16(Bt[n][k], At[m][k], acc[ai][bj][m][n], 0, 0, 0); __builtin_amdgcn_s_setprio(0); } while (0)
#define PG8_WAIT_V(n) asm volatile("s_waitcnt vmcnt(" #n ")" ::: "memory")
#define PG8_WAIT_L(n) asm volatile("s_waitcnt lgkmcnt(" #n ")" ::: "memory")
#define PG8_BAR __builtin_amdgcn_s_barrier()
#define PG8_SCHED __builtin_amdgcn_sched_barrier(0)
    Unit cur, nxt; int ui = 0;
    if (!S.next(0, cur)) return;
    f32x4 acc[2][2][4][2];
#pragma unroll
    for (int a = 0; a < 2; ++a)
#pragma unroll
        for (int b = 0; b < 2; ++b)
#pragma unroll
            for (int m = 0; m < 4; ++m)
#pragma unroll
                for (int n = 0; n < 2; ++n) acc[a][b][m][n] = (f32x4){0.f, 0.f, 0.f, 0.f};
    bf16x8 At[4][2], B0[2][2], B1[2][2];
    const char* cA = (const char*)g.A + (size_t)cur.pm * tstep + (size_t)cur.ko * 2; const char* cB = (const char*)g.Bt + (size_t)cur.pn * tstep + (size_t)cur.ko * 2;
    S.a_ready(cur);
    if constexpr (SP2) {
        PG8_STAGE(PG8_SB(0, 0), cB, voffB); PG8_STAGE(PG8_SB(0, 1), cB + hstep, voffB); PG8_STAGE(PG8_SA(0, 0), cA, voffA); PG8_STAGE(PG8_SA(0, 1), cA + hstep, voffA);
        if (wr == 1) PG8_BAR;
        PG8_WAIT_V(2); PG8_BAR;
        PG8_STAGE(PG8_SB(1, 0), cB + kstep, voffB); PG8_STAGE(PG8_SA(1, 0), cA + kstep, voffA); PG8_STAGE(PG8_SB(1, 1), cB + hstep + kstep, voffB);
        PG8_WAIT_V(6); PG8_BAR;
    } else {
        PG8_STAGE(PG8_SB(0, 0), cB, voffB); PG8_STAGE(PG8_SA(0, 0), cA, voffA); PG8_STAGE(PG8_SB(0, 1), cB + hstep, voffB); PG8_STAGE(PG8_SA(0, 1), cA + hstep, voffA);
        if (wr == 1) PG8_BAR;
        PG8_WAIT_V(4); PG8_BAR;
        PG8_STAGE(PG8_SB(1, 0), cB + kstep, voffB); PG8_STAGE(PG8_SA(1, 0), cA + kstep, voffA); PG8_STAGE(PG8_SB(1, 1), cB + hstep + kstep, voffB);
        PG8_WAIT_V(6); PG8_BAR;
    }
    for (;;) {
        const bool has_next = S.next(ui + 1, nxt);
        const char* nA = has_next ? (const char*)g.A + (size_t)nxt.pm * tstep + (size_t)nxt.ko * 2 : cA; const char* nB = has_next ? (const char*)g.Bt + (size_t)nxt.pn * tstep + (size_t)nxt.ko * 2 : cB;
        for (int t = 0; t < nt; t += 2) {
            const bool last = (t == nt - 2);
            const char* a1 = cA + (size_t)(t + 1) * kstep;
            const char* a2 = last ? nA : cA + (size_t)(t + 2) * kstep; const char* b2 = last ? nB : cB + (size_t)(t + 2) * kstep;
            const char* a3 = a2 + kstep; const char* b3 = b2 + kstep;
            if (last && has_next) S.a_ready(nxt);
            if constexpr (SP2) {
            PG8_LDB(B0, 0, 0); PG8_LDB(B1, 0, 1); PG8_SCHED; PG8_LDA(At, 0, 0); PG8_STAGE(PG8_SA(1, 1), a1 + hstep, voffA);
            PG8_WAIT_V(8); PG8_WAIT_L(0); PG8_BAR; PG8_MMA(0, 0, At, B0); PG8_MMA(0, 1, At, B1); PG8_BAR; PG8_SCHED;
            PG8_LDA(At, 0, 1); PG8_STAGE(PG8_SB(0, 0), b2, voffB); PG8_STAGE(PG8_SB(0, 1), b2 + hstep, voffB); PG8_STAGE(PG8_SA(0, 0), a2, voffA);
            PG8_WAIT_V(8); PG8_WAIT_L(0); PG8_BAR; if constexpr (!HALFM) { PG8_MMA(1, 0, At, B0); PG8_MMA(1, 1, At, B1); } PG8_BAR; PG8_SCHED;
            PG8_LDB(B0, 1, 0); PG8_LDB(B1, 1, 1); PG8_SCHED; PG8_LDA(At, 1, 0); PG8_STAGE(PG8_SA(0, 1), a2 + hstep, voffA);
            PG8_WAIT_V(8); PG8_WAIT_L(0); PG8_BAR; PG8_MMA(0, 0, At, B0); PG8_MMA(0, 1, At, B1); PG8_BAR; PG8_SCHED;
            PG8_LDA(At, 1, 1); PG8_STAGE(PG8_SB(1, 0), b3, voffB); PG8_STAGE(PG8_SB(1, 1), b3 + hstep, voffB); PG8_STAGE(PG8_SA(1, 0), a3, voffA);
            PG8_WAIT_V(8); PG8_WAIT_L(0); PG8_BAR; if constexpr (!HALFM) { PG8_MMA(1, 0, At, B0); PG8_MMA(1, 1, At, B1); } PG8_BAR; PG8_SCHED;
            } else {
            PG8_LDB(B0, 0, 0); PG8_SCHED; PG8_LDA(At, 0, 0); PG8_STAGE(PG8_SA(1, 1), a1 + hstep, voffA);
            PG8_WAIT_L(8); PG8_BAR; PG8_WAIT_L(0); PG8_MMA(0, 0, At, B0); PG8_BAR; PG8_SCHED;
            PG8_LDB(B1, 0, 1); PG8_STAGE(PG8_SB(0, 0), b2, voffB);
            PG8_BAR; PG8_WAIT_L(0); PG8_MMA(0, 1, At, B1); PG8_BAR;
            PG8_LDA(At, 0, 1); PG8_STAGE(PG8_SA(0, 0), a2, voffA);
            PG8_BAR; PG8_WAIT_L(0); PG8_MMA(1, 0, At, B0); PG8_BAR; PG8_SCHED;
            PG8_STAGE(PG8_SB(0, 1), b2 + hstep, voffB);
            PG8_WAIT_V(6); PG8_BAR; PG8_MMA(1, 1, At, B1); PG8_BAR;
            PG8_LDB(B0, 1, 0); PG8_SCHED; PG8_LDA(At, 1, 0); PG8_STAGE(PG8_SA(0, 1), a2 + hstep, voffA);
            PG8_WAIT_L(8); PG8_BAR; PG8_WAIT_L(0); PG8_MMA(0, 0, At, B0); PG8_BAR; PG8_SCHED;
            PG8_LDB(B1, 1, 1); PG8_STAGE(PG8_SB(1, 0), b3, voffB);
            PG8_BAR; PG8_WAIT_L(0); PG8_MMA(0, 1, At, B1); PG8_BAR;
            PG8_LDA(At, 1, 1); PG8_STAGE(PG8_SA(1, 0), a3, voffA);
            PG8_BAR; PG8_WAIT_L(0); PG8_MMA(1, 0, At, B0); PG8_BAR; PG8_SCHED;
            PG8_STAGE(PG8_SB(1, 1), b3 + hstep, voffB);
            PG8_WAIT_V(6); PG8_BAR; PG8_MMA(1, 1, At, B1); PG8_BAR;
            }
        }
        if constexpr (ALIGN_EPI) { if (wr == 0) PG8_BAR; }
        if constexpr (!Epi::AFTER_DRAIN) { E(acc, cur, wr, wc, fr, fq); S.done(cur); }
        if (!has_next) break;
#pragma unroll
        for (int a = 0; a < 2; ++a)
#pragma unroll
            for (int b = 0; b < 2; ++b)
#pragma unroll
                for (int m = 0; m < 4; ++m)
#pragma unroll
                    for (int n = 0; n < 2; ++n) acc[a][b][m][n] = (f32x4){0.f, 0.f, 0.f, 0.f};
        cur = nxt; cA = nA; cB = nB; ++ui;
        if constexpr (ALIGN_EPI) { if (wr == 1) PG8_BAR; }
    }
    PG8_WAIT_V(0);
    if constexpr (!ALIGN_EPI) { if (wr == 0) PG8_BAR; }
    PG8_BAR;
    if constexpr (Epi::AFTER_DRAIN) { E.fused(acc, cur, wr, wc, fr, fq, lds, wid, lane); S.done(cur); }
#undef PG8_SA
#undef PG8_SB
#undef PG8_STAGE
#undef PG8_LDA
#undef PG8_LDB
#undef PG8_MMA
#undef PG8_WAIT_V
#undef PG8_WAIT_L
#undef PG8_BAR
#undef PG8_SCHED
}
}


constexpr int RING_OFF = 0, RING_BYTES = 139264;
constexpr int LDSCTL_OFF = RING_BYTES, MISC_OFF = LDSCTL_OFF + 320;
constexpr int LDS_BYTES = 147456;
static_assert(MISC_OFF + 128 <= LDS_BYTES, "LDS map");

#define GAS __attribute__((address_space(1)))
#define LAS __attribute__((address_space(3)))
typedef unsigned short bf16;
typedef unsigned v4u __attribute__((ext_vector_type(4)));
typedef unsigned v2u __attribute__((ext_vector_type(2)));
typedef float f32x4 __attribute__((ext_vector_type(4)));
typedef float f32x16 __attribute__((ext_vector_type(16)));
typedef short bf16x8 __attribute__((ext_vector_type(8)));
typedef short s16x4 __attribute__((ext_vector_type(4)));
typedef GAS unsigned gu32;
#define RLX_AGENT __ATOMIC_RELAXED, __HIP_MEMORY_SCOPE_AGENT
#define LDS_WAIT() asm volatile("s_waitcnt lgkmcnt(0)" ::: "memory")
#define VM_WAIT() asm volatile("s_waitcnt vmcnt(0)" ::: "memory")
__device__ __forceinline__ unsigned f2bf(float f) { unsigned u = __builtin_bit_cast(unsigned, f); return (u + 0x7fffu + ((u >> 16) & 1u)) >> 16; }
__device__ __forceinline__ unsigned pk2(float lo, float hi) { return f2bf(lo) | (f2bf(hi) << 16); }
__device__ __forceinline__ float bflo(unsigned w) { return __builtin_bit_cast(float, w << 16); }
__device__ __forceinline__ float bfhi(unsigned w) { return __builtin_bit_cast(float, w & 0xffff0000u); }
using pg8::ex2; using pg8::sigm; using pg8::silu_f;
__device__ __forceinline__ int fresh_lane() { int l = threadIdx.x & 63; asm volatile("" : "+v"(l)); return l; }
__device__ __forceinline__ int fresh_tid() { int t = threadIdx.x; asm volatile("" : "+v"(t)); return t; }
#define XB_TMO      128
#define XB_XCNT(j)  (256  + 64 * (j))
#define XB_XSUB(j)  (1280 + 64 * (j))
#define XB_XGEN(j)  (2304 + 64 * (j))
#define XB_TOP      3328
#define XB_TOPGEN   3392
#define XCD_BAR_WORDS 3456
#define XB_SPIN_CAP (1u << 18)

__device__ __forceinline__ unsigned xb_ld(unsigned* p)              { return __hip_atomic_load(p, __ATOMIC_RELAXED, __HIP_MEMORY_SCOPE_AGENT); }
__device__ __forceinline__ unsigned xb_add(unsigned* p, unsigned v) { return __hip_atomic_fetch_add(p, v, __ATOMIC_RELAXED, __HIP_MEMORY_SCOPE_AGENT); }
__device__ __forceinline__ unsigned xb_xcc_id() { return (unsigned)__builtin_amdgcn_s_getreg((3 << 11) | 20) & 0xFu; }
#define XB_SPIN(cond, bar) do { unsigned _sp = 0; while (cond) { __builtin_amdgcn_s_sleep(1); \
    if ((++_sp & 255u) == 0u) { if (xb_ld(&(bar)[XB_TMO])) break; if (_sp > XB_SPIN_CAP) { atomicAdd(&(bar)[XB_TMO], 1u); break; } } } } while (0)

struct XcdBarrier {
    unsigned* bar; unsigned x;
    volatile LAS unsigned* st;
};

__device__ __forceinline__ XcdBarrier xcd_barrier_post(unsigned* bar, volatile LAS unsigned* st) {
    XcdBarrier b; b.bar = bar; b.x = xb_xcc_id(); b.st = st;
    if (threadIdx.x == 0) (void)xb_add(&bar[XB_XCNT(b.x)], 1u);
    return b;
}
__device__ __forceinline__ void xcd_barrier_complete(unsigned* bar, unsigned x, unsigned& nloc, unsigned& nx) {
    const unsigned G = gridDim.x * gridDim.y * gridDim.z;
    unsigned sum, cnt, mine, sp = 0u;
    for (;;) {
        sum = 0u; cnt = 0u; mine = 0u;
#pragma unroll
        for (unsigned j = 0; j < 16; ++j) { const unsigned c = xb_ld(&bar[XB_XCNT(j)]); sum += c; cnt += (c > 0u) ? 1u : 0u; mine = (j == x) ? c : mine; }
        if (sum == G) break;
        __builtin_amdgcn_s_sleep(1);
        if ((++sp & 255u) == 0u) { if (xb_ld(&bar[XB_TMO])) break; if (sp > XB_SPIN_CAP) { atomicAdd(&bar[XB_TMO], 1u); break; } }
    }
    nloc = mine > 0u ? mine : 1u; nx = cnt > 0u ? cnt : 1u;
}

__device__ __forceinline__ void xcd_barrier(const XcdBarrier& b) {
    asm volatile("s_waitcnt vmcnt(0)" ::: "memory");
    __syncthreads();
    if (threadIdx.x == 0) {
        unsigned* bar = b.bar;
        __builtin_amdgcn_s_waitcnt(0);
        unsigned nloc = b.st[0], nx = b.st[1];
        if (nloc == 0u) { xcd_barrier_complete(bar, b.x, nloc, nx); b.st[0] = nloc; b.st[1] = nx; }
        const unsigned old = xb_add(&bar[XB_XSUB(b.x)], 1u);
        const unsigned gen = old / nloc;
        if (old + 1u == (gen + 1u) * nloc) {
            __builtin_amdgcn_fence(__ATOMIC_RELEASE, "agent");
            asm volatile("s_waitcnt vmcnt(0)" ::: "memory");
            const unsigned og = xb_add(&bar[XB_TOP], 1u);
            const unsigned tg = og / nx;
            if (og + 1u == (tg + 1u) * nx) xb_add(&bar[XB_TOPGEN], 1u);
            else XB_SPIN(xb_ld(&bar[XB_TOPGEN]) == tg, bar);
            __builtin_amdgcn_fence(__ATOMIC_ACQUIRE, "agent");
            xb_add(&bar[XB_XGEN(b.x)], 1u);
            asm volatile("s_waitcnt vmcnt(0)" ::: "memory");
        } else {
            XB_SPIN(xb_ld(&bar[XB_XGEN(b.x)]) == gen, bar);
            __builtin_amdgcn_fence(__ATOMIC_ACQUIRE, "agent");
            asm volatile("s_waitcnt vmcnt(0)" ::: "memory");
        }
    }
    __syncthreads();
}

struct Args { const float* in[32]; float* out; unsigned char* ws; };
struct Frame {
    LAS unsigned char* lds;
    volatile LAS unsigned* MISC;
    gu32* ctl;
    int tid, lane, wave, G;
};
__device__ const float INV_FREQ[32] = {1.000000000e+00f, 7.498942614e-01f, 5.623413324e-01f, 4.216965139e-01f, 3.162277639e-01f, 2.371373773e-01f, 1.778279394e-01f, 1.333521307e-01f,
    1.000000015e-01f, 7.498941571e-02f, 5.623413250e-02f, 4.216965288e-02f, 3.162277490e-02f, 2.371373773e-02f, 1.778279431e-02f, 1.333521493e-02f,
    9.999999776e-03f, 7.498941850e-03f, 5.623413250e-03f, 4.216964822e-03f, 3.162277630e-03f, 2.371373586e-03f, 1.778279431e-03f, 1.333521446e-03f,
    1.000000047e-03f, 7.498942432e-04f, 5.623413017e-04f, 4.216965172e-04f, 3.162277571e-04f, 2.371373703e-04f, 1.778279402e-04f, 1.333521504e-04f};

__device__ __forceinline__ float wave_sum(float v) {
#pragma unroll
    for (int o = 1; o < 64; o <<= 1) v += __shfl_xor(v, o);
    return v;
}
__device__ __forceinline__ void sincos_d(double a, double& s, double& c) {
    const double k = __builtin_rint(a * 0.15915494309189535);
    double r = __builtin_fma(-k, 6.283185307179586, a);
    r = __builtin_fma(-k, 2.4492935982947064e-16, r);
    const double r2 = r * r;
    double sa = 1.0, ca = 1.0;
#pragma unroll
    for (int n = 15; n >= 1; --n) { sa = 1.0 - sa * r2 * (1.0 / (double)((2 * n) * (2 * n + 1))); ca = 1.0 - ca * r2 * (1.0 / (double)((2 * n - 1) * (2 * n))); }
    s = sa * r; c = ca;
}

__device__ __forceinline__ void p0_item(const float* colp, int ldw, const float* gain, int K, bf16* WT, int v0, int k0, LAS float* scr, int lane) {
#pragma unroll
    for (int i = 0; i < 32; ++i) { const int kk = 2 * i + (lane >> 5); float w = colp ? colp[(size_t)(k0 + kk) * ldw] : 0.f; if (gain) w *= gain[k0 + kk]; scr[kk * 33 + (lane & 31)] = w; }
    LDS_WAIT(); asm volatile("" ::: "memory");
    const int c = lane & 7;
#pragma unroll
    for (int j = 0; j < 4; ++j) { const int n = (lane >> 3) + 8 * j; const LAS float* s = scr + (8 * c) * 33 + n;
        v4u o; o.x = pk2(s[0 * 33], s[1 * 33]); o.y = pk2(s[2 * 33], s[3 * 33]); o.z = pk2(s[4 * 33], s[5 * 33]); o.w = pk2(s[6 * 33], s[7 * 33]);
        *(GAS v4u*)(WT + (size_t)(v0 + n) * K + k0 + 8 * c) = o; }
    LDS_WAIT(); asm volatile("" ::: "memory");
}
__device__ __forceinline__ int win_src(int v) {
    if (v < 5120) return v;
    if (v < 8192) { const int isk = v >= 6656, w = v - (isk ? 6656 : 5120), head = w >> 6, j = w & 63, dim = (j & 1) ? 32 + (j >> 1) : (j >> 1); return (isk ? 6688 : 5152) + head * 64 + dim; }
    if (v < 9728) return 8224 + (v - 8192);
    if (v < 10752) return 9760 + (v - 9728);
    if (v < 11776) return 10784 + (v - 10752);
    if (v < 11808) return 5120 + (v - 11776);
    return -1;
}
__device__ __forceinline__ void norm_row_bf16(const float* xrow, const float* gain, bf16* orow, int lane) {
    const GAS f32x4* xr = (const GAS f32x4*)xrow + lane; const GAS f32x4* gr = (const GAS f32x4*)gain + lane;
    f32x4 v[4]; float s = 0.f;
#pragma unroll
    for (int j = 0; j < 4; ++j) { v[j] = xr[64 * j]; s += (v[j].x * v[j].x + v[j].y * v[j].y) + (v[j].z * v[j].z + v[j].w * v[j].w); }
    const float rstd = 1.0f / sqrtf(wave_sum(s) * (1.f / 1024.f) + EPS);
    GAS unsigned long long* o8 = (GAS unsigned long long*)orow + lane;
#pragma unroll
    for (int j = 0; j < 4; ++j) { const f32x4 g = gr[64 * j];
        o8[64 * j] = (unsigned long long)pk2(v[j].x * rstd * g.x, v[j].y * rstd * g.y) | ((unsigned long long)pk2(v[j].z * rstd * g.z, v[j].w * rstd * g.w) << 32); }
}
__device__ __forceinline__ void norm_row_f32(const float* xrow, const float* gain, float* orow, int lane) {
    const GAS f32x4* xr = (const GAS f32x4*)xrow + lane; const GAS f32x4* gr = (const GAS f32x4*)gain + lane;
    f32x4 v[4]; float s = 0.f;
#pragma unroll
    for (int j = 0; j < 4; ++j) { v[j] = xr[64 * j]; s += (v[j].x * v[j].x + v[j].y * v[j].y) + (v[j].z * v[j].z + v[j].w * v[j].w); }
    const float rstd = 1.0f / sqrtf(wave_sum(s) * (1.f / 1024.f) + EPS);
    GAS f32x4* o = (GAS f32x4*)orow + lane;
#pragma unroll
    for (int j = 0; j < 4; ++j) { const f32x4 g = gr[64 * j]; o[64 * j] = v[j] * rstd * g; }
}
template <bool OUTF32> __device__ __forceinline__ void norm_rows4(const float* x, const float* gain, void* out, size_t m, size_t step, int lane) {
    f32x4 v[4][4]; float s[4];
#pragma unroll
    for (int r = 0; r < 4; ++r) { const GAS f32x4* xr = (const GAS f32x4*)(x + (m + r * step) * 1024) + lane;
#pragma unroll
        for (int j = 0; j < 4; ++j) v[r][j] = xr[64 * j]; }
    f32x4 g[4];
#pragma unroll
    for (int j = 0; j < 4; ++j) g[j] = ((const GAS f32x4*)gain)[lane + 64 * j];
#pragma unroll
    for (int r = 0; r < 4; ++r) { float q = 0.f;
#pragma unroll
        for (int j = 0; j < 4; ++j) q += (v[r][j].x * v[r][j].x + v[r][j].y * v[r][j].y) + (v[r][j].z * v[r][j].z + v[r][j].w * v[r][j].w);
        s[r] = q; }
#pragma unroll
    for (int o = 1; o < 64; o <<= 1) {
#pragma unroll
        for (int r = 0; r < 4; ++r) s[r] += __shfl_xor(s[r], o); }
#pragma unroll
    for (int r = 0; r < 4; ++r) { const float rstd = 1.0f / sqrtf(s[r] * (1.f / 1024.f) + EPS);
        if (OUTF32) { GAS f32x4* o = (GAS f32x4*)((float*)out + (m + r * step) * 1024) + lane;
#pragma unroll
            for (int j = 0; j < 4; ++j) o[64 * j] = v[r][j] * rstd * g[j]; }
        else { GAS unsigned long long* o8 = (GAS unsigned long long*)((bf16*)out + (m + r * step) * 1024) + lane;
#pragma unroll
            for (int j = 0; j < 4; ++j) o8[64 * j] = (unsigned long long)pk2(v[r][j].x * rstd * g[j].x, v[r][j].y * rstd * g[j].y) | ((unsigned long long)pk2(v[r][j].z * rstd * g[j].z, v[r][j].w * rstd * g[j].w) << 32); }
    }
}
__device__ __forceinline__ void final_rows4(const bf16* h, const float* gain, float* out, size_t m, size_t step, int nrows, int lane) {
    v4u v[4][2]; float s[4];
#pragma unroll
    for (int r = 0; r < 4; ++r) { const size_t mm = m + (r < nrows ? r : 0) * step; v[r][0] = ((const GAS v4u*)(h + mm * 1024))[lane]; v[r][1] = ((const GAS v4u*)(h + mm * 1024))[lane + 64]; }
    f32x4 g[4];
#pragma unroll
    for (int j = 0; j < 2; ++j) { g[2 * j] = ((const GAS f32x4*)gain)[128 * j + 2 * lane]; g[2 * j + 1] = ((const GAS f32x4*)gain)[128 * j + 2 * lane + 1]; }
    float x[4][16];
#pragma unroll
    for (int r = 0; r < 4; ++r) { float q = 0.f;
#pragma unroll
        for (int j = 0; j < 2; ++j) { const v4u w = v[r][j];
            x[r][8 * j + 0] = bflo(w.x); x[r][8 * j + 1] = bfhi(w.x); x[r][8 * j + 2] = bflo(w.y); x[r][8 * j + 3] = bfhi(w.y); x[r][8 * j + 4] = bflo(w.z); x[r][8 * j + 5] = bfhi(w.z); x[r][8 * j + 6] = bflo(w.w); x[r][8 * j + 7] = bfhi(w.w); }
#pragma unroll
        for (int e = 0; e < 16; ++e) q += x[r][e] * x[r][e];
        s[r] = q; }
#pragma unroll
    for (int o = 1; o < 64; o <<= 1) {
#pragma unroll
        for (int r = 0; r < 4; ++r) s[r] += __shfl_xor(s[r], o); }
#pragma unroll
    for (int r = 0; r < 4; ++r) if (r < nrows) { const float rstd = 1.0f / sqrtf(s[r] * (1.f / 1024.f) + EPS);
        GAS f32x4* o = (GAS f32x4*)(out + (m + r * step) * 1024);
#pragma unroll
        for (int j = 0; j < 2; ++j) { o[128 * j + 2 * lane] = (f32x4){x[r][8 * j] * rstd * g[2 * j][0], x[r][8 * j + 1] * rstd * g[2 * j][1], x[r][8 * j + 2] * rstd * g[2 * j][2], x[r][8 * j + 3] * rstd * g[2 * j][3]};
            o[128 * j + 2 * lane + 1] = (f32x4){x[r][8 * j + 4] * rstd * g[2 * j + 1][0], x[r][8 * j + 5] * rstd * g[2 * j + 1][1], x[r][8 * j + 6] * rstd * g[2 * j + 1][2], x[r][8 * j + 7] * rstd * g[2 * j + 1][3]}; }
    }
}
__device__ __forceinline__ void norm_phase(const Frame& F, const float* HR, const float* gain, bf16* U) {
    const int gw = blockIdx.x * NWAVES + F.wave, NGW = F.G * NWAVES;
    for (int m = gw; m < M_REAL; m += NGW) norm_row_bf16(HR + (size_t)m * 1024, gain, U + (size_t)m * 1024, fresh_lane());
}

__device__ __forceinline__ void p0_prologue(const Frame& F, const Args& A) {
    unsigned char* ws = A.ws;
    LAS float* scr = (LAS float*)(F.lds + RING_OFF + F.wave * 16384);
    const int gw = blockIdx.x * NWAVES + F.wave, NGW = F.G * NWAVES, lane = fresh_lane();
    constexpr int NK[10] = {16, 44, 16, 32, 8, 16, 16, 44, 16, 4};
    constexpr int NN[10] = {176, 32, 376, 32, 32, 32, 176, 32, 32, 32};
    int total = 0;
#pragma unroll
    for (int k = 0; k < 10; ++k) total += NK[k] * NN[k];
    for (int it = gw; it < total; it += NGW) {
        int r = it, kind = 0;
#pragma unroll
        for (int k = 0; k < 9; ++k) { if (kind == k && r >= NK[k] * NN[k]) { r -= NK[k] * NN[k]; kind = k + 1; } }
        int nn = 32, K = 1024, ldw = 1024; const float* src = nullptr; const float* gain = nullptr; bf16* WT = nullptr;
        switch (kind) {
            case 0: nn = 176; K = 1024; ldw = 2816; WT = (bf16*)(ws + WS_W1A); break;
            case 1: nn = 32; K = 2816; ldw = 1024; src = A.in[12]; WT = (bf16*)(ws + WS_W2A); break;
            case 2: nn = 376; K = 1024; ldw = 11808; src = A.in[14]; gain = A.in[13]; WT = (bf16*)(ws + WS_WIN); break;
            case 3: nn = 32; K = 2048; ldw = 1024; src = A.in[21]; gain = A.in[20]; WT = (bf16*)(ws + WS_WOS); break;
            case 4: nn = 32; K = 512; ldw = 1024; src = A.in[22]; WT = (bf16*)(ws + WS_WOA); break;
            case 5: nn = 32; K = 1024; ldw = 1024; src = A.in[23]; WT = (bf16*)(ws + WS_WOUT); break;
            case 6: nn = 176; K = 1024; ldw = 2816; gain = A.in[24]; WT = (bf16*)(ws + WS_W1B); break;
            case 7: nn = 32; K = 2816; ldw = 1024; src = A.in[27]; WT = (bf16*)(ws + WS_W2B); break;
            case 8: nn = 32; K = 1024; ldw = 1024; src = A.in[29]; gain = A.in[28]; WT = (bf16*)(ws + WS_WPG); break;
            default: nn = 32; K = 256; ldw = 1024; src = A.in[30]; WT = (bf16*)(ws + WS_WPP); break;
        }
        const int kb = r / nn, nb = r % nn, v = nb * 32 + (lane & 31);
        const float* colp;
        if (kind == 0 || kind == 6) { const int tile = v >> 8, w = v & 255; colp = (w < 128 ? A.in[kind == 0 ? 10 : 25] : A.in[kind == 0 ? 11 : 26]) + tile * 128 + (w & 127); }
        else if (kind == 2) { const int sc = win_src(v); colp = sc >= 0 ? src + sc : nullptr; }
        else colp = src + v;
        p0_item(colp, ldw, gain, K, WT, nb * 32, kb * 64, scr, lane);
    }
    {
        float* cs = (float*)(ws + WS_CS);
        const int gt = blockIdx.x * (NWAVES * 64) + fresh_tid(), NT = F.G * NWAVES * 64;
        for (int e = gt; e < 8193 * 32; e += NT) { const int pos = e >> 5, i = e & 31; const float ang = (float)pos * INV_FREQ[i];
            double s, c; sincos_d((double)ang, s, c); cs[(size_t)pos * 64 + (i >> 1) * 4 + (i & 1) * 2 + 0] = (float)c; cs[(size_t)pos * 64 + (i >> 1) * 4 + (i & 1) * 2 + 1] = (float)s; }
    }
    {
        bf16* U = (bf16*)(ws + WS_U); bf16* PB = (bf16*)(ws + WS_PB); bf16* YG = (bf16*)(ws + WS_YG); bf16* AO = (bf16*)(ws + WS_AO);
        for (int m = gw; m + 3 * NGW < P_ROWS; m += 4 * NGW) {
            f32x4 p[4];
#pragma unroll
            for (int r = 0; r < 4; ++r) p[r] = ((const GAS f32x4*)(A.in[7] + ((size_t)m + (size_t)r * NGW) * 256))[lane];
            norm_rows4<false>(A.in[0], A.in[9], U, (size_t)m, (size_t)NGW, lane);
#pragma unroll
            for (int r = 0; r < 4; ++r) { const size_t mm = (size_t)m + (size_t)r * NGW;
                ((GAS v2u*)(PB + mm * 256))[lane] = (v2u){pk2(p[r].x, p[r].y), pk2(p[r].z, p[r].w)};
                if (lane < 3) ((float*)(ws + WS_SQ2))[(size_t)lane * M_PAD + mm] = 0.f; }
        }
        const int mrest = (P_ROWS / (4 * NGW)) * (4 * NGW);
        for (int m = mrest + gw; m < M_PAD; m += NGW) {
            if (m < M_REAL) {
                const float* xr = m < P_ROWS ? A.in[0] + (size_t)m * 1024 : A.in[1] + (size_t)(m - P_ROWS) * 1024;
                norm_row_bf16(xr, A.in[9], U + (size_t)m * 1024, lane);
                const float* pr = m < P_ROWS ? A.in[7] + (size_t)m * 256 : A.in[8] + (size_t)(m - P_ROWS) * 256;
                const f32x4 p = ((const GAS f32x4*)pr)[lane];
                ((GAS v2u*)(PB + (size_t)m * 256))[lane] = (v2u){pk2(p.x, p.y), pk2(p.z, p.w)};
            } else {
                const v4u z = (v4u){0u, 0u, 0u, 0u};
                ((GAS v4u*)(U + (size_t)m * 1024))[lane] = z; ((GAS v4u*)(U + (size_t)m * 1024))[lane + 64] = z;
                if (lane < 32) ((GAS v4u*)(PB + (size_t)m * 256))[lane] = z;
#pragma unroll
                for (int j = 0; j < 4; ++j) ((GAS v4u*)(YG + (size_t)m * 2048))[lane + 64 * j] = z;
                ((GAS v4u*)(AO + (size_t)m * 512))[lane] = z;
                if (lane == 0) ((float*)(ws + WS_RSTD))[m] = 0.f;
            }
            if (lane < 3) ((float*)(ws + WS_SQ2))[(size_t)lane * M_PAD + m] = 0.f;
            if (m >= P_ROWS) {
                GAS f32x4* hr = (GAS f32x4*)((float*)(ws + WS_HR) + (size_t)m * 1024) + lane; GAS f32x4* t1 = (GAS f32x4*)((float*)(ws + WS_T1S) + (size_t)(m - P_ROWS) * 1024) + lane;
#pragma unroll
                for (int j = 0; j < 4; ++j) { hr[64 * j] = m < M_REAL ? ((const GAS f32x4*)(A.in[1] + (size_t)(m - P_ROWS) * 1024))[lane + 64 * j] : (f32x4){0.f, 0.f, 0.f, 0.f}; t1[64 * j] = (f32x4){0.f, 0.f, 0.f, 0.f}; }
            }
        }
    }
}
__device__ __forceinline__ void sample_norm_phase(const Frame& F, const float* HR, bf16* HB, float* ssq) {
    const int gw = blockIdx.x * NWAVES + F.wave, NGW = F.G * NWAVES, lane = fresh_lane();
    for (int m = P_ROWS + gw; m < M_REAL; m += NGW) {
        const GAS f32x4* xr = (const GAS f32x4*)(HR + (size_t)m * 1024) + lane; float s = 0.f;
        GAS unsigned long long* o8 = (GAS unsigned long long*)(HB + (size_t)m * 1024) + lane;
#pragma unroll
        for (int j = 0; j < 4; ++j) { const f32x4 v = xr[64 * j]; s += (v.x * v.x + v.y * v.y) + (v.z * v.z + v.w * v.w);
            o8[64 * j] = (unsigned long long)pk2(v.x, v.y) | ((unsigned long long)pk2(v.z, v.w) << 32); }
        s = wave_sum(s);
        if (lane == 0) ssq[m] = s;
    }
}

typedef short v4i16_t __attribute__((ext_vector_type(4)));
constexpr float LOG2E = 1.4426950408889634f;
constexpr size_t O_KVS0 = pg8::EpiWin::O_KVS0, O_KVS1 = pg8::EpiWin::O_KVS1, O_KVS2 = pg8::EpiWin::O_KVS2, O_CONVS = pg8::EpiWin::O_CONVS, O_SSMS = pg8::EpiWin::O_SSMS, O_SSMP = pg8::EpiWin::O_SSMP;
__device__ __forceinline__ s16x4 trr(LAS unsigned char* p) { return __builtin_bit_cast(s16x4, __builtin_amdgcn_ds_read_tr16_b64_v4i16((LAS v4i16_t*)p)); }
__device__ __forceinline__ bf16x8 cat8(s16x4 lo, s16x4 hi) { return (bf16x8){lo[0], lo[1], lo[2], lo[3], hi[0], hi[1], hi[2], hi[3]}; }
__device__ __forceinline__ bf16x8 packf8(float a0, float a1, float a2, float a3, float a4, float a5, float a6, float a7) {
    v4u w; w.x = pg8::cvt_pk_bf16(a0, a1); w.y = pg8::cvt_pk_bf16(a2, a3); w.z = pg8::cvt_pk_bf16(a4, a5); w.w = pg8::cvt_pk_bf16(a6, a7); return __builtin_bit_cast(bf16x8, w); }
#define MFMA32(a, b, c) __builtin_amdgcn_mfma_f32_32x32x16_bf16((a), (b), (c), 0, 0, 0)

__device__ __forceinline__ void conv_prepass(const Frame& F, const Args& A) {
    unsigned char* ws = A.ws;
    const int gt = blockIdx.x * (NWAVES * 64) + fresh_tid(), NT = F.G * NWAVES * 64, nper = NT / 128, nthr = nper * 128;
    if (gt >= nthr) return;
    const int cc = 256 + gt % 128, c0 = 8 * cc;
    float cw0[8], cw1[8], cw2[8], cw3[8], cbs[8];
#pragma unroll
    for (int e = 0; e < 8; ++e) { cw0[e] = A.in[15][c0 + e]; cw1[e] = A.in[15][3072 + c0 + e]; cw2[e] = A.in[15][2 * 3072 + c0 + e]; cw3[e] = A.in[15][3 * 3072 + c0 + e]; cbs[e] = A.in[16][c0 + e]; }
    const bf16* XB = (const bf16*)(ws + WS_XBC) + c0; bf16* XC = (bf16*)(ws + WS_XC) + c0;
    for (int seg = gt / 128; seg < P_ROWS / 16; seg += nper) {
        const int row0 = seg * 16, tb = row0 & (SEQ_T - 1);
        float r0[8], r1[8], r2[8], cur[8];
#pragma unroll
        for (int i = 0; i < 19; ++i) {
            const v4u rw = (tb - 3 + i >= 0) ? *(const GAS v4u*)(XB + (size_t)(row0 - 3 + i) * 3072) : (v4u){0u, 0u, 0u, 0u};
            cur[0] = bflo(rw.x); cur[1] = bfhi(rw.x); cur[2] = bflo(rw.y); cur[3] = bfhi(rw.y); cur[4] = bflo(rw.z); cur[5] = bfhi(rw.z); cur[6] = bflo(rw.w); cur[7] = bfhi(rw.w);
            if (i >= 3) {
                float y[8];
#pragma unroll
                for (int e = 0; e < 8; ++e) { const float v = cbs[e] + cw0[e] * r0[e] + cw1[e] * r1[e] + cw2[e] * r2[e] + cw3[e] * cur[e]; y[e] = silu_f(v); }
                *(GAS bf16x8*)(XC + (size_t)(row0 + i - 3) * 3072) = packf8(y[0], y[1], y[2], y[3], y[4], y[5], y[6], y[7]);
            }
#pragma unroll
            for (int e = 0; e < 8; ++e) { r0[e] = r1[e]; r1[e] = r2[e]; r2[e] = cur[e]; }
        }
    }
}

constexpr int XS_ = 144, BS_ = 272;
constexpr int L_XT = 0, L_XST = L_XT + 128 * XS_, L_BT = L_XST + 128 * XS_, L_CT = L_BT + 128 * BS_, L_ST = L_CT + 128 * BS_, L_ARR = L_ST + 64 * BS_, L_CWL = L_ARR + 3072, L_HALO = L_CWL + 1280, L_SSD_END = L_HALO + 8 * 2 * 3 * XS_;
static_assert(L_SSD_END <= RING_BYTES, "SSD LDS map");

__device__ __forceinline__ void ssd_stream(const Frame& F, const Args& A, int sidx) {
    unsigned char* ws = A.ws;
    const int lane = fresh_lane(), w = F.wave, tid = fresh_tid(), r32 = lane & 31, hh = lane >> 5;
    const int qq = (lane & 15) >> 2, pp = lane & 3, cb16 = (lane >> 4) & 1;
    const int pairi = (sidx & 7) * 4 + (sidx >> 6), b = pairi >> 2, g = pairi & 3, hd = g * 8 + ((sidx >> 3) & 7);
    LAS unsigned char* XT = F.lds + L_XT; LAS unsigned char* XST = F.lds + L_XST; LAS unsigned char* BT = F.lds + L_BT; LAS unsigned char* CT = F.lds + L_CT; LAS unsigned char* ST = F.lds + L_ST;
    const float a2 = -ex2(A.in[18][hd] * LOG2E) * LOG2E;
    const float Dsk = A.in[19][hd];
    const int pt = w >> 2, lt = w < 4 ? w : 7 - w, nt = w & 3;
    f32x16 st;
#pragma unroll
    for (int i = 0; i < 16; ++i) st[i] = 0.f;
    const GAS unsigned char* XCg = (const GAS unsigned char*)(ws + WS_XC) + (size_t)b * SEQ_T * 3072 * 2;
    const GAS unsigned char* XBg = (const GAS unsigned char*)(ws + WS_XBC) + (size_t)b * SEQ_T * 3072 * 2;
    const GAS unsigned char* DTg = (const GAS unsigned char*)(ws + WS_DT) + ((size_t)b * SEQ_T * 32 + hd) * 4;
    const GAS unsigned char* Zg = (const GAS unsigned char*)(ws + WS_Z) + (size_t)b * SEQ_T * 2048 * 2;
    GAS unsigned char* YGg = (GAS unsigned char*)(ws + WS_YG) + (size_t)b * SEQ_T * 2048 * 2;
    GAS unsigned char* SSQg = (GAS unsigned char*)(ws + WS_SSQ) + (size_t)b * SEQ_T * 64 * 4;
    const unsigned xoff = (unsigned)((tid >> 3) * 3072 + hd * 64 + 8 * (tid & 7)) * 2u;
    const unsigned boff = (unsigned)((tid >> 4) * 3072 + 2048 + g * 128 + 8 * (tid & 15)) * 2u;
    const int xdst = (tid >> 3) * XS_ + 16 * (tid & 7), bdst = (tid >> 4) * BS_ + 16 * (tid & 15);
    const unsigned doff = (unsigned)(2 * lane) * 128u;
    const int hrow = 8 * w - 3 + (lane >> 3);
    const unsigned hoff = (unsigned)(hd * 64 + 8 * (lane & 7)) * 2u;
    LAS unsigned char* HAL = F.lds + L_HALO + w * (2 * 3 * XS_);
    LAS float* CWL = (LAS float*)(F.lds + L_CWL);
    if (tid < 320) CWL[tid] = tid < 256 ? A.in[15][(tid >> 6) * 3072 + hd * 64 + (tid & 63)] : A.in[16][hd * 64 + (tid & 63)];
    const int lcol = 32 * lt + r32;
    const unsigned zoff = (unsigned)(lcol * 2048 + hd * 64 + 32 * pt + 4 * hh) * 2u;
    const unsigned soff = (unsigned)(lcol * 64 + hd * 2 + pt) * 4u;
    v4u pfx[2], pfh[2], pfb[4], pfc[4]; float pd0 = 0.f, pd1 = 0.f;
#pragma unroll
    for (int i = 0; i < 2; ++i) { pfx[i] = *(const GAS v4u*)(XBg + (size_t)i * (64 * 6144) + xoff);
        pfh[i] = (lane < 24 && hrow + 64 * i >= 0) ? *(const GAS v4u*)(XBg + (ptrdiff_t)(hrow + 64 * i) * 6144 + hoff) : (v4u){0u, 0u, 0u, 0u}; }
#pragma unroll
    for (int i = 0; i < 4; ++i) { pfb[i] = *(const GAS v4u*)(XCg + (size_t)i * (32 * 6144) + boff); pfc[i] = *(const GAS v4u*)(XCg + (size_t)i * (32 * 6144) + 1024 + boff); }
    if (w == 0) { pd0 = *(const GAS float*)(DTg + doff); pd1 = *(const GAS float*)(DTg + 128 + doff); }

#define SSD_SCAN(ARRP) do { if (w == 0) { LAS float* arr_ = (ARRP); const float a0 = pd0 * a2, a1 = pd1 * a2; float x = a0 + a1; \
            _Pragma("unroll") for (int o = 1; o < 64; o <<= 1) { const float v = __shfl_up(x, o); if (lane >= o) x += v; } \
            arr_[2 * lane] = x - a1; arr_[2 * lane + 1] = x; arr_[128 + 2 * lane] = pd0; arr_[128 + 2 * lane + 1] = pd1; \
            const float E_ = __shfl(x, lane | 15); arr_[256 + 2 * lane] = ex2(E_ - (x - a1)) * pd0; arr_[256 + 2 * lane + 1] = ex2(E_ - x) * pd1; } } while (0)
    SSD_SCAN((LAS float*)(F.lds + L_ARR));
    for (int ck = 0; ck < 64; ++ck) {
        const int t0 = ck * 128;
        LAS float* arr = (LAS float*)(F.lds + L_ARR + (ck & 1) * 1536);
        __syncthreads();
#pragma unroll
        for (int q4 = 0; q4 < 4; ++q4) { v2u o; o.x = pg8::cvt_pk_bf16(st[4 * q4], st[4 * q4 + 1]); o.y = pg8::cvt_pk_bf16(st[4 * q4 + 2], st[4 * q4 + 3]);
            *(LAS v2u*)(ST + (32 * pt + r32) * BS_ + (32 * nt + 8 * q4 + 4 * hh) * 2) = o; }
        {
            const float aL = arr[127];
#pragma unroll
            for (int i = 0; i < 2; ++i) { *(LAS v4u*)(XST + xdst + 64 * i * XS_) = pfx[i]; if (lane < 24) *(LAS v4u*)(HAL + (3 * i + (lane >> 3)) * XS_ + 16 * (lane & 7)) = pfh[i]; }
            v4u rw[2][4];
#pragma unroll
            for (int i = 0; i < 2; ++i)
#pragma unroll
                for (int k = 0; k < 4; ++k) { const int lr = (lane >> 3) + k - 3;
                    LAS unsigned char* src = lr >= 0 ? XST + (8 * w + lr + 64 * i) * XS_ + 16 * (lane & 7) : HAL + (3 * i + 3 + lr) * XS_ + 16 * (lane & 7);
                    rw[i][k] = *(LAS v4u*)src; }
            f32x4 cwa[5], cwb[5];
#pragma unroll
            for (int k = 0; k < 5; ++k) { cwa[k] = *(LAS f32x4*)(CWL + 64 * k + 8 * (lane & 7)); cwb[k] = *(LAS f32x4*)(CWL + 64 * k + 8 * (lane & 7) + 4); }
            asm volatile("s_waitcnt lgkmcnt(0)" ::: "memory");
#pragma unroll
            for (int i = 0; i < 2; ++i) {
                const int row = (tid >> 3) + 64 * i;
                float y[8];
#pragma unroll
                for (int e = 0; e < 8; ++e) y[e] = e < 4 ? cwa[4][e] : cwb[4][e - 4];
#pragma unroll
                for (int k = 0; k < 4; ++k) { const v4u r = rw[i][k];
                    y[0] += cwa[k][0] * bflo(r.x); y[1] += cwa[k][1] * bfhi(r.x); y[2] += cwa[k][2] * bflo(r.y); y[3] += cwa[k][3] * bfhi(r.y);
                    y[4] += cwb[k][0] * bflo(r.z); y[5] += cwb[k][1] * bfhi(r.z); y[6] += cwb[k][2] * bflo(r.w); y[7] += cwb[k][3] * bfhi(r.w); }
#pragma unroll
                for (int e = 0; e < 8; ++e) y[e] = silu_f(y[e]);
                *(LAS bf16x8*)(XT + xdst + 64 * i * XS_) = packf8(y[0], y[1], y[2], y[3], y[4], y[5], y[6], y[7]);
                const float te = ex2(aL - arr[row]) * arr[128 + row];
                *(LAS bf16x8*)(XST + xdst + 64 * i * XS_) = packf8(y[0] * te, y[1] * te, y[2] * te, y[3] * te, y[4] * te, y[5] * te, y[6] * te, y[7] * te);
            }
#pragma unroll
            for (int i = 0; i < 4; ++i) { *(LAS v4u*)(BT + bdst + 32 * i * BS_) = pfb[i]; *(LAS v4u*)(CT + bdst + 32 * i * BS_) = pfc[i]; }
        }
        v2u zw[4];
        { const GAS unsigned char* zb = Zg + (size_t)t0 * 4096;
#pragma unroll
          for (int q4 = 0; q4 < 4; ++q4) zw[q4] = *(const GAS v2u*)(zb + 16 * q4 + zoff); }
        if (ck < 63) {
            const GAS unsigned char* xb = XCg + (size_t)(t0 + 128) * 6144; const GAS unsigned char* rb = XBg + (size_t)(t0 + 128) * 6144;
#pragma unroll
            for (int i = 0; i < 2; ++i) { pfx[i] = *(const GAS v4u*)(rb + (size_t)i * (64 * 6144) + xoff);
                if (lane < 24) pfh[i] = *(const GAS v4u*)(rb + (ptrdiff_t)(hrow + 64 * i) * 6144 + hoff); }
#pragma unroll
            for (int i = 0; i < 4; ++i) { pfb[i] = *(const GAS v4u*)(xb + (size_t)i * (32 * 6144) + boff); pfc[i] = *(const GAS v4u*)(xb + (size_t)i * (32 * 6144) + 1024 + boff); }
            if (w == 0) { const GAS unsigned char* db = DTg + (size_t)(t0 + 128) * 128; pd0 = *(const GAS float*)(db + doff); pd1 = *(const GAS float*)(db + 128 + doff); }
        }
        __syncthreads();
        const float acs_l = arr[lcol];
        int r32o = r32; asm volatile("" : "+v"(r32o));
        bf16x8 cf[8], af[8];
#pragma unroll
        for (int s = 0; s < 8; ++s) { cf[s] = *(LAS bf16x8*)(CT + lcol * BS_ + (16 * s + 8 * hh) * 2); af[s] = *(LAS bf16x8*)(ST + (32 * pt + r32) * BS_ + (16 * s + 8 * hh) * 2); }
        __builtin_amdgcn_sched_barrier(0);
        f32x16 Y;
#pragma unroll
        for (int i = 0; i < 16; ++i) Y[i] = 0.f;
#pragma unroll
        for (int s = 0; s < 8; ++s) Y = MFMA32(af[s], cf[s], Y);
        { const float el = ex2(acs_l);
#pragma unroll
          for (int i = 0; i < 16; ++i) Y[i] *= el; }
#pragma unroll 1
        for (int sti = 0; sti <= lt; ++sti) {
            {
                bf16x8 bfA[8]; f32x4 as4[4], dt4[4]; s16x4 xlo[2], xhi[2];
#pragma unroll
                for (int s = 0; s < 8; ++s) bfA[s] = *(LAS bf16x8*)(BT + (32 * sti + r32) * BS_ + (16 * s + 8 * hh) * 2);
                __builtin_amdgcn_sched_barrier(0);
                f32x16 Gt;
#pragma unroll
                for (int i = 0; i < 16; ++i) Gt[i] = 0.f;
#pragma unroll
                for (int s = 0; s < 8; ++s) Gt = MFMA32(bfA[s], cf[s], Gt);
#pragma unroll
                for (int s2 = 0; s2 < 2; ++s2) { LAS unsigned char* xa = XT + (32 * sti + 16 * s2 + 4 * hh + qq) * XS_ + (32 * pt + 16 * cb16 + 4 * pp) * 2; xlo[s2] = trr(xa); xhi[s2] = trr(xa + 8 * XS_); }
                if (sti < lt) {
                    const float fl = ex2(acs_l - arr[32 * sti + 31]);
#pragma unroll
                    for (int q4 = 0; q4 < 4; ++q4) { as4[q4] = *(LAS f32x4*)(arr + 256 + 32 * sti + 8 * q4 + 4 * hh);
#pragma unroll
                        for (int e = 0; e < 4; ++e) Gt[4 * q4 + e] = Gt[4 * q4 + e] * as4[q4][e] * fl; }
                } else {
#pragma unroll
                    for (int q4 = 0; q4 < 4; ++q4) { const int s0 = 32 * sti + 8 * q4 + 4 * hh; as4[q4] = *(LAS f32x4*)(arr + s0); dt4[q4] = *(LAS f32x4*)(arr + 128 + s0); }
#pragma unroll
                    for (int q4 = 0; q4 < 4; ++q4) {
#pragma unroll
                        for (int e = 0; e < 4; ++e) { float wv = Gt[4 * q4 + e] * ex2(fminf(acs_l - as4[q4][e], 0.f)) * dt4[q4][e]; if ((8 * q4 + 4 * hh + e) > r32o) wv = 0.f; Gt[4 * q4 + e] = wv; }
                    }
                }
#pragma unroll
                for (int s2 = 0; s2 < 2; ++s2) {
                    const bf16x8 wf = packf8(Gt[8 * s2], Gt[8 * s2 + 1], Gt[8 * s2 + 2], Gt[8 * s2 + 3], Gt[8 * s2 + 4], Gt[8 * s2 + 5], Gt[8 * s2 + 6], Gt[8 * s2 + 7]);
                    Y = MFMA32(cat8(xlo[s2], xhi[s2]), wf, Y);
                }
                __builtin_amdgcn_sched_barrier(0);
            }
        }
        {
            GAS unsigned char* yb = YGg + (size_t)t0 * 4096;
            float ssq = 0.f;
#pragma unroll
            for (int q4 = 0; q4 < 4; ++q4) {
                const int p0 = 32 * pt + 8 * q4 + 4 * hh;
                const v2u xw = *(LAS v2u*)(XT + lcol * XS_ + p0 * 2);
                const float y0 = (Y[4 * q4 + 0] + Dsk * bflo(xw.x)) * silu_f(bflo(zw[q4].x)), y1 = (Y[4 * q4 + 1] + Dsk * bfhi(xw.x)) * silu_f(bfhi(zw[q4].x));
                const float y2 = (Y[4 * q4 + 2] + Dsk * bflo(xw.y)) * silu_f(bflo(zw[q4].y)), y3 = (Y[4 * q4 + 3] + Dsk * bfhi(xw.y)) * silu_f(bfhi(zw[q4].y));
                ssq += (y0 * y0 + y1 * y1) + (y2 * y2 + y3 * y3);
                v2u o; o.x = pg8::cvt_pk_bf16(y0, y1); o.y = pg8::cvt_pk_bf16(y2, y3);
                *(GAS v2u*)(yb + 16 * q4 + zoff) = o;
            }
            ssq += __shfl_xor(ssq, 32);
            if (hh == 0) *(GAS float*)(SSQg + (size_t)t0 * 256 + soff) = ssq;
        }
        {
            const float eL = ex2(arr[127]);
#pragma unroll
            for (int i = 0; i < 16; ++i) st[i] *= eL;
#pragma unroll
            for (int kg = 0; kg < 2; ++kg) {
                s16x4 alo[4], ahi[4], blo[4], bhi[4];
#pragma unroll
                for (int k4 = 0; k4 < 4; ++k4) { const int ks = 4 * kg + k4;
                    LAS unsigned char* ba = BT + (16 * ks + 8 * hh + qq) * BS_ + (32 * nt + 16 * cb16 + 4 * pp) * 2;
                    LAS unsigned char* xa = XST + (16 * ks + 8 * hh + qq) * XS_ + (32 * pt + 16 * cb16 + 4 * pp) * 2;
                    alo[k4] = trr(ba); ahi[k4] = trr(ba + 4 * BS_); blo[k4] = trr(xa); bhi[k4] = trr(xa + 4 * XS_); }
                __builtin_amdgcn_sched_barrier(0);
#pragma unroll
                for (int k4 = 0; k4 < 4; ++k4) st = MFMA32(cat8(alo[k4], ahi[k4]), cat8(blo[k4], bhi[k4]), st);
            }
        }
        if (ck < 63) SSD_SCAN((LAS float*)(F.lds + L_ARR + ((ck + 1) & 1) * 1536));
    }
#undef SSD_SCAN
    {
        float* so = A.out + O_SSMP + ((size_t)(b * 32 + hd) * 64 + 32 * pt + r32) * 128 + 32 * nt + 4 * hh;
#pragma unroll
        for (int q4 = 0; q4 < 4; ++q4) *(GAS f32x4*)(so + 8 * q4) = (f32x4){st[4 * q4], st[4 * q4 + 1], st[4 * q4 + 2], st[4 * q4 + 3]};
    }
    __syncthreads();
}

constexpr int KS_ = 144, L_AK = 0, L_AV = 384 * KS_;
static_assert(2 * 384 * KS_ <= RING_BYTES, "attention LDS map");
struct AttnU { size_t tokbase; int dil, k0, colq, g, h; };
__device__ __forceinline__ AttnU attn_unit_decode(int u) {
    AttnU r; const int g = u >> 11, r1 = u & 2047, b = r1 >> 8, r2 = r1 & 255, h = r2 >> 5, blk = r2 & 31;
    const int dsh = 2 * g, res = blk >> (5 - dsh), qb = blk & ((32 >> dsh) - 1);
    r.dil = 1 << dsh; r.tokbase = (size_t)b * SEQ_T + res; r.k0 = 256 * qb - 128; r.colq = (g * 8 + h) * 64; r.g = g; r.h = h; return r;
}
__device__ __forceinline__ void attn_prefetch(const AttnU& U, bool cont, const bf16* Kb, const bf16* Vb, const bf16* Qb, int tid, int wave, int lane, v4u (&pk)[6], v4u (&pv)[6], bf16x8 (&qn)[4]) {
    const int r0 = cont ? 128 : 0, nch = cont ? 4 : 6;
#pragma unroll
    for (int i = 0; i < 6; ++i) { const int ci = tid + 512 * i, row = r0 + (ci >> 3), c8 = ci & 7, key = U.k0 + row;
        if (i >= nch) { pk[i] = (v4u){0u, 0u, 0u, 0u}; pv[i] = pk[i]; }
        else if (key >= 0) { const size_t o = (U.tokbase + (size_t)U.dil * key) * AW + U.colq + 8 * c8; pk[i] = *(const GAS v4u*)(Kb + o); pv[i] = *(const GAS v4u*)(Vb + o); }
        else { pk[i] = (v4u){0u, 0u, 0u, 0u}; pv[i] = pk[i]; } }
    const bf16* qrow = Qb + (U.tokbase + (size_t)U.dil * (U.k0 + 128 + 32 * wave + (lane & 31))) * AW + U.colq + 8 * (lane >> 5);
#pragma unroll
    for (int s = 0; s < 4; ++s) qn[s] = *(const GAS bf16x8*)(qrow + 16 * s);
}
__device__ __forceinline__ void attn_prompt_phase(const Frame& F, const Args& A) {
    unsigned char* ws = A.ws;
    const int lane = fresh_lane(), w = F.wave, tid = fresh_tid(), r32 = lane & 31, hh = lane >> 5;
    const int qq = (lane & 15) >> 2, pp = lane & 3, cb16 = (lane >> 4) & 1;
    const bf16* Qb = (const bf16*)(ws + WS_Q); const bf16* Kb = (const bf16*)(ws + WS_K); const bf16* Vb = (const bf16*)(ws + WS_V);
    constexpr int NU = 3 * 8 * 8 * 32;
    const int per = (NU + F.G - 1) / F.G, lo = blockIdx.x * per, hi = (lo + per < NU) ? lo + per : NU;
    if (lo >= hi) return;
    LAS unsigned char* AK = F.lds + L_AK; LAS unsigned char* AV = F.lds + L_AV;
    v4u pk[6], pv[6]; bf16x8 qn[4];
    AttnU U = attn_unit_decode(lo);
    attn_prefetch(U, false, Kb, Vb, Qb, tid, w, lane, pk, pv, qn);
    int rot = 0; bool cont = false;
    for (int u = lo; u < hi; ++u) {
        __syncthreads();
        rot = cont ? (rot + 8 >= 12 ? rot - 4 : rot + 8) : 0;
        { const int r0 = cont ? 128 : 0, nch = cont ? 4 : 6;
#pragma unroll
          for (int i = 0; i < 6; ++i) if (i < nch) { const int ci = tid + 512 * i, rl = r0 + (ci >> 3), c8 = ci & 7; int sl = rot + (rl >> 5); sl = sl >= 12 ? sl - 12 : sl;
              const int row = sl * 32 + (rl & 31); *(LAS v4u*)(AK + row * KS_ + 16 * c8) = pk[i]; *(LAS v4u*)(AV + row * KS_ + 16 * c8) = pv[i]; } }
        bf16x8 qf[4];
#pragma unroll
        for (int s = 0; s < 4; ++s) qf[s] = qn[s];
        const AttnU C = U;
        if (u + 1 < hi) { U = attn_unit_decode(u + 1);
            cont = (((u + 1) >> 5) == (u >> 5)) && (U.tokbase == C.tokbase) && (U.k0 == C.k0 + 256);
            attn_prefetch(U, cont, Kb, Vb, Qb, tid, w, lane, pk, pv, qn); }
        __syncthreads();
        int r32o = r32; asm volatile("" : "+v"(r32o));
        const int tfirst = (C.k0 < 0) ? 4 - w : 0;
        float m = -INFINITY;
#pragma unroll
        for (int kt = 0; kt < 5; ++kt) {
            if (kt >= tfirst) {
                f32x16 S;
#pragma unroll
                for (int i = 0; i < 16; ++i) S[i] = 0.f;
                int sl = rot + w + kt; sl = sl >= 12 ? sl - 12 : sl;
                LAS unsigned char* kp = AK + (32 * sl + r32) * KS_ + 16 * hh;
                bf16x8 kf[4];
#pragma unroll
                for (int s = 0; s < 4; ++s) kf[s] = *(LAS bf16x8*)(kp + 32 * s);
                __builtin_amdgcn_sched_barrier(0);
#pragma unroll
                for (int s = 0; s < 4; ++s) S = MFMA32(kf[s], qf[s], S);
#pragma unroll
                for (int rr = 0; rr < 16; ++rr) { const int keyrow = (rr & 3) + 8 * (rr >> 2) + 4 * hh; float v = S[rr]; if (kt == 0 && keyrow < r32o) v = -INFINITY; if (kt == 4 && keyrow > r32o) v = -INFINITY; m = fmaxf(m, v); }
            }
        }
        m = fmaxf(m, __shfl_xor(m, 32));
        float lsum = 0.f;
        f32x16 O0, O1;
#pragma unroll
        for (int i = 0; i < 16; ++i) { O0[i] = 0.f; O1[i] = 0.f; }
#pragma unroll
        for (int kt = 0; kt < 5; ++kt) {
            if (kt >= tfirst) {
                f32x16 S;
#pragma unroll
                for (int i = 0; i < 16; ++i) S[i] = 0.f;
                int sl = rot + w + kt; sl = sl >= 12 ? sl - 12 : sl;
                LAS unsigned char* kp = AK + (32 * sl + r32) * KS_ + 16 * hh;
                bf16x8 kf[4]; s16x4 vlo0[2], vhi0[2], vlo1[2], vhi1[2];
#pragma unroll
                for (int s = 0; s < 4; ++s) kf[s] = *(LAS bf16x8*)(kp + 32 * s);
#pragma unroll
                for (int s2 = 0; s2 < 2; ++s2) { LAS unsigned char* va = AV + (32 * sl + 16 * s2 + 4 * hh + qq) * KS_ + (16 * cb16 + 4 * pp) * 2;
                    vlo0[s2] = trr(va); vhi0[s2] = trr(va + 8 * KS_); vlo1[s2] = trr(va + 64); vhi1[s2] = trr(va + 8 * KS_ + 64); }
                __builtin_amdgcn_sched_barrier(0);
#pragma unroll
                for (int s = 0; s < 4; ++s) S = MFMA32(kf[s], qf[s], S);
#pragma unroll
                for (int rr = 0; rr < 16; ++rr) { const int keyrow = (rr & 3) + 8 * (rr >> 2) + 4 * hh; float p = ex2(S[rr] - m); if (kt == 0 && keyrow < r32o) p = 0.f; if (kt == 4 && keyrow > r32o) p = 0.f; S[rr] = p; lsum += p; }
#pragma unroll
                for (int s2 = 0; s2 < 2; ++s2) {
                    const bf16x8 pf = packf8(S[8 * s2], S[8 * s2 + 1], S[8 * s2 + 2], S[8 * s2 + 3], S[8 * s2 + 4], S[8 * s2 + 5], S[8 * s2 + 6], S[8 * s2 + 7]);
                    O0 = MFMA32(cat8(vlo0[s2], vhi0[s2]), pf, O0);
                    O1 = MFMA32(cat8(vlo1[s2], vhi1[s2]), pf, O1);
                }
            }
        }
        lsum += __shfl_xor(lsum, 32);
        const float inv = 1.0f / lsum;
        const size_t orow = C.tokbase + (size_t)C.dil * (C.k0 + 128 + 32 * w + r32);
        bf16* op = (bf16*)(ws + WS_AOG) + (size_t)C.g * AOG_STRIDE + orow * 512 + C.h * 64 + 4 * hh;
#pragma unroll
        for (int q4 = 0; q4 < 4; ++q4) {
            v2u o; o.x = pg8::cvt_pk_bf16(O0[4 * q4] * inv, O0[4 * q4 + 1] * inv); o.y = pg8::cvt_pk_bf16(O0[4 * q4 + 2] * inv, O0[4 * q4 + 3] * inv);
            *(GAS v2u*)(op + 8 * q4) = o;
            v2u o2; o2.x = pg8::cvt_pk_bf16(O1[4 * q4] * inv, O1[4 * q4 + 1] * inv); o2.y = pg8::cvt_pk_bf16(O1[4 * q4 + 2] * inv, O1[4 * q4 + 3] * inv);
            *(GAS v2u*)(op + 32 + 8 * q4) = o2;
        }
        if (hh == 0) ((float*)(ws + WS_LSE))[(size_t)C.g * LSE_STRIDE + orow * 8 + C.h] = m + __builtin_amdgcn_logf(lsum);
    }
    __syncthreads();
}

__device__ __forceinline__ void attn_sample_item(const Frame& F, const Args& A, int it) {
    unsigned char* ws = A.ws;
    const int lane = fresh_lane(), kq = lane >> 2, part = lane & 3;
    const int b = it / 24, hq = it % 24, g = hq >> 3, h = hq & 7;
    const int W = 128 << (2 * g), dil = 1 << (2 * g);
    const float* cache = A.in[2 + g];
    const size_t row = (size_t)P_ROWS + b;
    const bf16* qrow = (const bf16*)(ws + WS_Q) + row * AW + hq * 64 + 32 * (part & 1);
    const bf16* krow = (const bf16*)(ws + WS_K) + row * AW + hq * 64 + 32 * (part & 1);
    const bf16* vrow = (const bf16*)(ws + WS_V) + row * AW + hq * 64;
    float qn[16]; float snew = 0.f;
#pragma unroll
    for (int c = 0; c < 4; ++c) {
        const v4u qw = *(const GAS v4u*)(qrow + 8 * c), kw = *(const GAS v4u*)(krow + 8 * c);
        const bool od = part >= 2;
        qn[4 * c + 0] = od ? bfhi(qw.x) : bflo(qw.x); qn[4 * c + 1] = od ? bfhi(qw.y) : bflo(qw.y); qn[4 * c + 2] = od ? bfhi(qw.z) : bflo(qw.z); qn[4 * c + 3] = od ? bfhi(qw.w) : bflo(qw.w);
        snew += qn[4 * c + 0] * (od ? bfhi(kw.x) : bflo(kw.x)) + qn[4 * c + 1] * (od ? bfhi(kw.y) : bflo(kw.y)) + qn[4 * c + 2] * (od ? bfhi(kw.z) : bflo(kw.z)) + qn[4 * c + 3] * (od ? bfhi(kw.w) : bflo(kw.w));
    }
    snew += __shfl_xor(snew, 1); snew += __shfl_xor(snew, 2);
    const float* kbase = cache + ((size_t)b * W * 2 + 0) * 512 + h * 64 + 16 * part;
    float sc[8];
#pragma unroll
    for (int jj = 0; jj < 8; ++jj) {
        const float* kr = kbase + (size_t)(W - dil * (kq + 16 * jj + 1)) * 1024;
        float acc = 0.f;
#pragma unroll
        for (int i = 0; i < 4; ++i) { const f32x4 kv = *(const GAS f32x4*)(kr + 4 * i); acc += (qn[4 * i] * kv[0] + qn[4 * i + 1] * kv[1]) + (qn[4 * i + 2] * kv[2] + qn[4 * i + 3] * kv[3]); }
        sc[jj] = acc;
    }
#pragma unroll
    for (int jj = 0; jj < 8; ++jj) { sc[jj] += __shfl_xor(sc[jj], 1); sc[jj] += __shfl_xor(sc[jj], 2); }
    float m = snew;
#pragma unroll
    for (int jj = 0; jj < 8; ++jj) m = fmaxf(m, sc[jj]);
#pragma unroll
    for (int o = 4; o < 64; o <<= 1) m = fmaxf(m, __shfl_xor(m, o));
    float lpart = 0.f;
#pragma unroll
    for (int jj = 0; jj < 8; ++jj) { sc[jj] = ex2(sc[jj] - m); lpart += sc[jj]; }
    const float pn = ex2(snew - m);
    const float lsum = wave_sum(lpart) * 0.25f + pn;
    const float* vbase = cache + ((size_t)b * W * 2 + 1) * 512 + h * 64 + lane;
    float o = pn * bflo((unsigned)vrow[lane]);
#pragma unroll
    for (int j2 = 0; j2 < 4; ++j2) {
        float vv[32];
#pragma unroll
        for (int kk = 0; kk < 32; ++kk) vv[kk] = vbase[(size_t)(W - dil * (kk + 32 * j2 + 1)) * 1024];
#pragma unroll
        for (int kk = 0; kk < 32; ++kk) o += __shfl(sc[2 * j2 + (kk >> 4)], 4 * (kk & 15)) * vv[kk];
    }
    o *= 1.0f / lsum;
    ((bf16*)(ws + WS_AOG))[(size_t)g * AOG_STRIDE + row * 512 + h * 64 + lane] = (bf16)f2bf(o);
    if (lane == 0) ((float*)(ws + WS_LSE))[(size_t)g * LSE_STRIDE + row * 8 + h] = m + __builtin_amdgcn_logf(lsum);
}

__device__ __forceinline__ float conv1(const float* sc, const bf16* nw, const float* cwp, const float* cbp, int c) {
    return silu_f(cbp[c] + cwp[c] * sc[c] + cwp[3072 + c] * sc[3072 + c] + cwp[2 * 3072 + c] * sc[2 * 3072 + c] + cwp[3 * 3072 + c] * bflo((unsigned)nw[c]));
}
__device__ __forceinline__ void ssd_sample_item(const Frame& F, const Args& A, int it) {
    unsigned char* ws = A.ws;
    const int lane = fresh_lane(), r32 = lane & 31, hh = lane >> 5;
    const int b = it >> 5, hd = it & 31, g = hd >> 3;
    const float* sc = A.in[5] + (size_t)b * 3 * 3072;
    const bf16* nw = (const bf16*)(ws + WS_XBC) + ((size_t)P_ROWS + b) * 3072;
    const float* cwp = A.in[15]; const float* cbp = A.in[16];
    const float xv = conv1(sc, nw, cwp, cbp, hd * 64 + lane);
    float Bv[4], Cv[4];
#pragma unroll
    for (int e = 0; e < 4; ++e) { Bv[e] = conv1(sc, nw, cwp, cbp, 2048 + g * 128 + 4 * r32 + e); Cv[e] = conv1(sc, nw, cwp, cbp, 2560 + g * 128 + 4 * r32 + e); }
    const size_t row = (size_t)P_ROWS + b;
    const float dt = ((const float*)(ws + WS_DT))[row * 32 + hd];
    const float dA = ex2(dt * (-ex2(A.in[18][hd] * LOG2E)) * LOG2E);
    const float Dsk = A.in[19][hd];
    const float* sin_ = A.in[6] + ((size_t)(b * 32 + hd) * 64) * 128 + 4 * r32;
    float* sout = A.out + O_SSMS + ((size_t)(b * 32 + hd) * 64) * 128 + 4 * r32;
    float yp[32];
#pragma unroll
    for (int i8 = 0; i8 < 2; ++i8) {
        f32x4 sv[16];
#pragma unroll
        for (int k = 0; k < 16; ++k) sv[k] = *(const GAS f32x4*)(sin_ + (size_t)(2 * (16 * i8 + k) + hh) * 128);
#pragma unroll
        for (int k = 0; k < 16; ++k) { const int i = 16 * i8 + k, p = 2 * i + hh;
            const float dx = dt * __shfl(xv, p);
            f32x4 sn; sn[0] = dA * sv[k][0] + dx * Bv[0]; sn[1] = dA * sv[k][1] + dx * Bv[1]; sn[2] = dA * sv[k][2] + dx * Bv[2]; sn[3] = dA * sv[k][3] + dx * Bv[3];
            *(GAS f32x4*)(sout + (size_t)p * 128) = sn;
            yp[i] = (Cv[0] * sn[0] + Cv[1] * sn[1]) + (Cv[2] * sn[2] + Cv[3] * sn[3]); }
    }
#pragma unroll
    for (int d = 16; d >= 1; d >>= 1) {
        const bool up = (r32 & d) != 0;
#pragma unroll
        for (int i = 0; i < d; ++i) { const float give = up ? yp[i] : yp[i + d], keep = up ? yp[i + d] : yp[i]; yp[i] = keep + __shfl_xor(give, d); }
    }
    const float ykeep = yp[0];
    const int pl = 2 * r32 + hh;
    const float xl = __shfl(xv, pl);
    const float z = bflo((unsigned)((const bf16*)(ws + WS_Z))[row * 2048 + hd * 64 + pl]);
    const float yg = (ykeep + Dsk * xl) * silu_f(z);
    ((bf16*)(ws + WS_YG))[row * 2048 + hd * 64 + pl] = (bf16)f2bf(yg);
    const float ssq = wave_sum(yg * yg);
    if (lane == 0) { float* q = (float*)(ws + WS_SSQ) + row * 64 + hd * 2; q[0] = ssq; q[1] = 0.f; }
}

__device__ __forceinline__ void emit_kv_rows4(const bf16* const (&kp)[4], const bf16* const (&vp)[4], float* const (&dp)[4], int lane) {
    const int hl = lane >> 3, c = lane & 7;
    v4u a[4], b[4], w[4];
#pragma unroll
    for (int r = 0; r < 4; ++r) { a[r] = *(const GAS v4u*)(kp[r] + hl * 64 + 16 * (c & 3)); b[r] = *(const GAS v4u*)(kp[r] + hl * 64 + 16 * (c & 3) + 8); w[r] = *(const GAS v4u*)(vp[r] + 8 * lane); }
#pragma unroll
    for (int r = 0; r < 4; ++r) { f32x4 o0, o1;
        if (c < 4) { o0 = (f32x4){bflo(a[r].x), bflo(a[r].y), bflo(a[r].z), bflo(a[r].w)}; o1 = (f32x4){bflo(b[r].x), bflo(b[r].y), bflo(b[r].z), bflo(b[r].w)}; }
        else       { o0 = (f32x4){bfhi(a[r].x), bfhi(a[r].y), bfhi(a[r].z), bfhi(a[r].w)}; o1 = (f32x4){bfhi(b[r].x), bfhi(b[r].y), bfhi(b[r].z), bfhi(b[r].w)}; }
        float* d = dp[r] + hl * 64 + 8 * c; *(GAS f32x4*)d = o0; *(GAS f32x4*)(d + 4) = o1;
        float* q = dp[r] + 512 + 8 * lane; *(GAS f32x4*)q = (f32x4){bflo(w[r].x), bfhi(w[r].x), bflo(w[r].y), bfhi(w[r].y)}; *(GAS f32x4*)(q + 4) = (f32x4){bflo(w[r].z), bfhi(w[r].z), bflo(w[r].w), bfhi(w[r].w)}; }
}
__device__ __forceinline__ void emit_outputs(const Frame& F, const Args& A) {
    unsigned char* ws = A.ws;
    const int gw = blockIdx.x * NWAVES + F.wave, NGW = F.G * NWAVES, lane = fresh_lane();
    const bf16* Kb = (const bf16*)(ws + WS_K); const bf16* Vb = (const bf16*)(ws + WS_V);
    constexpr int NR = 8 * 2688 + 3 * 128;
    for (int r = gw; r < NR; r += 4 * NGW) {
        const bf16* kp[4]; const bf16* vp[4]; float* dp[4];
#pragma unroll
        for (int k = 0; k < 4; ++k) {
            int rr = r + k * NGW; if (rr >= NR) rr = r;
            if (rr < 8 * 2688) { const int b = rr / 2688, q = rr % 2688;
                const int g = q < 128 ? 0 : (q < 640 ? 1 : 2), tw = q - (g == 0 ? 0 : (g == 1 ? 128 : 640)), W = 128 << (2 * g);
                const size_t row = (size_t)b * SEQ_T + (SEQ_T - W) + tw;
                kp[k] = Kb + row * AW + g * 512; vp[k] = Vb + row * AW + g * 512;
                dp[k] = A.out + (g == 0 ? pg8::EpiWin::O_KVP0 : (g == 1 ? pg8::EpiWin::O_KVP1 : pg8::EpiWin::O_KVP2)) + ((size_t)b * W + tw) * 1024;
            } else { const int q = rr - 8 * 2688, g = q >> 7, b = q & 127; const size_t row = (size_t)P_ROWS + b;
                kp[k] = Kb + row * AW + g * 512; vp[k] = Vb + row * AW + g * 512;
                dp[k] = A.out + (g == 0 ? O_KVS0 : (g == 1 ? O_KVS1 : O_KVS2)) + (size_t)b * 1024; }
        }
        emit_kv_rows4(kp, vp, dp, lane);
    }
    const bf16* XB = (const bf16*)(ws + WS_XBC);
    const int gt = blockIdx.x * (NWAVES * 64) + fresh_tid(), NT = F.G * NWAVES * 64;
    for (int e = gt; e < 8 * 3 * 384; e += NT) { const int rr = e / 384, c8 = e % 384, b = rr / 3, k = rr % 3;
        const v4u a = *(const GAS v4u*)(XB + ((size_t)b * SEQ_T + SEQ_T - 3 + k) * 3072 + 8 * c8);
        float* d = A.out + pg8::EpiWin::O_CONVP + (size_t)rr * 3072 + 8 * c8; *(GAS f32x4*)d = (f32x4){bflo(a.x), bfhi(a.x), bflo(a.y), bfhi(a.y)}; *(GAS f32x4*)(d + 4) = (f32x4){bflo(a.z), bfhi(a.z), bflo(a.w), bfhi(a.w)}; }
    for (int e = gt; e < 128 * 384; e += NT) { const int b = e / 384, c8 = e % 384;
        const v4u a = *(const GAS v4u*)(XB + ((size_t)P_ROWS + b) * 3072 + 8 * c8);
        float* d = A.out + O_CONVS + ((size_t)b * 3 + 2) * 3072 + 8 * c8; *(GAS f32x4*)d = (f32x4){bflo(a.x), bfhi(a.x), bflo(a.y), bfhi(a.y)}; *(GAS f32x4*)(d + 4) = (f32x4){bflo(a.z), bfhi(a.z), bflo(a.w), bfhi(a.w)}; }
    for (int e = gt; e < 128 * 2 * 768; e += NT) { const int bb = e / 1536, r = e % 1536, rw = r / 768, c4 = r % 768;
        *(GAS f32x4*)(A.out + O_CONVS + ((size_t)bb * 3 + rw) * 3072 + 4 * c4) = *(const GAS f32x4*)(A.in[5] + ((size_t)bb * 3 + rw + 1) * 3072 + 4 * c4); }
}

__device__ __forceinline__ void mixer_phase_a(const Frame& F, const Args& A) {
    conv_prepass(F, A);
    attn_prompt_phase(F, A);
}
__device__ __forceinline__ void mixer_phase_b(const Frame& F, const Args& A) {
    for (int s = blockIdx.x; s < 256; s += F.G) ssd_stream(F, A, s);
    const int gw = blockIdx.x * NWAVES + F.wave, NGW = F.G * NWAVES;
    for (int it = gw; it < 128 * 24; it += NGW) attn_sample_item(F, A, it);
    for (int it = gw; it < 128 * 32; it += NGW) ssd_sample_item(F, A, it);
    emit_outputs(F, A);
}

__device__ __forceinline__ void combine_phase(const Frame& F, const Args& A) {
    unsigned char* ws = A.ws;
    const int gw = blockIdx.x * NWAVES + F.wave, NGW = F.G * NWAVES, lane = fresh_lane();
    const bf16* AOG = (const bf16*)(ws + WS_AOG); const float* LSE = (const float*)(ws + WS_LSE);
    const int h = lane >> 3;
    for (int m0 = gw; m0 < M_REAL; m0 += 4 * NGW) {
        float l0[4], l1[4], l2[4], sq[4]; v4u a[4], bq[4], c[4];
#pragma unroll
        for (int r = 0; r < 4; ++r) { const int mr = m0 + r * NGW; const size_t m = (size_t)(mr < M_REAL ? mr : m0);
            l0[r] = LSE[m * 8 + h]; l1[r] = LSE[LSE_STRIDE + m * 8 + h]; l2[r] = LSE[2 * LSE_STRIDE + m * 8 + h];
            a[r] = *(const GAS v4u*)(AOG + m * 512 + 8 * lane); bq[r] = *(const GAS v4u*)(AOG + AOG_STRIDE + m * 512 + 8 * lane); c[r] = *(const GAS v4u*)(AOG + 2 * AOG_STRIDE + m * 512 + 8 * lane);
            sq[r] = ((const float*)(ws + WS_SSQ))[m * 64 + lane]; }
#pragma unroll
        for (int r = 0; r < 4; ++r) { const int mr = m0 + r * NGW;
            const float mx = fmaxf(l0[r], fmaxf(l1[r], l2[r]));
            float w0 = ex2(l0[r] - mx), w1 = ex2(l1[r] - mx), w2 = ex2(l2[r] - mx);
            const float inv = 1.0f / (w0 + w1 + w2); w0 *= inv; w1 *= inv; w2 *= inv;
            v4u o;
            o.x = pg8::cvt_pk_bf16(w0 * bflo(a[r].x) + w1 * bflo(bq[r].x) + w2 * bflo(c[r].x), w0 * bfhi(a[r].x) + w1 * bfhi(bq[r].x) + w2 * bfhi(c[r].x));
            o.y = pg8::cvt_pk_bf16(w0 * bflo(a[r].y) + w1 * bflo(bq[r].y) + w2 * bflo(c[r].y), w0 * bfhi(a[r].y) + w1 * bfhi(bq[r].y) + w2 * bfhi(c[r].y));
            o.z = pg8::cvt_pk_bf16(w0 * bflo(a[r].z) + w1 * bflo(bq[r].z) + w2 * bflo(c[r].z), w0 * bfhi(a[r].z) + w1 * bfhi(bq[r].z) + w2 * bfhi(c[r].z));
            o.w = pg8::cvt_pk_bf16(w0 * bflo(a[r].w) + w1 * bflo(bq[r].w) + w2 * bflo(c[r].w), w0 * bfhi(a[r].w) + w1 * bfhi(bq[r].w) + w2 * bfhi(c[r].w));
            const float s = wave_sum(sq[r]);
            if (mr < M_REAL) { *(GAS v4u*)((bf16*)(ws + WS_AO) + (size_t)mr * 512 + 8 * lane) = o;
                if (lane == 0) ((float*)(ws + WS_RSTD))[mr] = 1.0f / sqrtf(s * (1.f / 2048.f) + EPS); }
        }
    }
}

__global__ void __launch_bounds__(NWAVES * 64, 2) fwd(Args args) {
    extern __shared__ __attribute__((aligned(16))) unsigned char lds[];
    Frame F;
    F.lds = (LAS unsigned char*)lds;
    F.MISC = (volatile LAS unsigned*)(F.lds + MISC_OFF);
    F.tid = threadIdx.x; F.lane = F.tid & 63; F.wave = __builtin_amdgcn_readfirstlane(F.tid >> 6);
    F.G = gridDim.x;
    unsigned char* ws = args.ws;
    F.ctl = (gu32*)(ws + WS_CTL);
    for (int u = F.tid; u < (LDS_BYTES - LDSCTL_OFF) / 4; u += NWAVES * 64) ((LAS unsigned*)(F.lds + LDSCTL_OFF))[u] = 0u;
    __syncthreads();
    if (F.tid < 32) ((LAS float*)(F.lds + LDSCTL_OFF))[F.tid] = INV_FREQ[F.tid];
    XcdBarrier bar = xcd_barrier_post((unsigned*)(F.ctl + CW_BAR), F.MISC + 8);
#define GRID_BAR() xcd_barrier(bar)
    const int bx = (int)blockIdx.x;
    int kple; asm volatile("s_mov_b32 %0, 256" : "=s"(kple));

    p0_prologue(F, args);
    GRID_BAR();
#define GEMM_REG(EPI, AOFF, BOFF, NN, KK, ...) do { pg8::Gemm g{(bf16*)(ws + (AOFF)), (bf16*)(ws + (BOFF)), P_ROWS, (NN), (KK), (KK)}; pg8::StaticOrder S; S.init(P_ROWS, (NN), F.G, bx); EPI E{__VA_ARGS__}; \
        pg8::gemm_phase<EPI, pg8::StaticOrder, true, true>(F.lds + RING_OFF, g, S, E); } while (0)
#define GEMM_REGV(EPI, AOFF, BOFF, NN, KK, ...) do { pg8::Gemm g{(bf16*)(ws + (AOFF)), (bf16*)(ws + (BOFF)), P_ROWS, (NN), (KK), (KK)}; pg8::StaticOrder S; S.init(P_ROWS, (NN), F.G, bx, 1); EPI E{__VA_ARGS__}; \
        pg8::gemm_phase<EPI, pg8::StaticOrder, true, true>(F.lds + RING_OFF, g, S, E); } while (0)
#define GEMM_SMP(EPI, AOFF, BOFF, NN, KK, PP_, ...) do { pg8::Gemm g{(bf16*)(ws + (AOFF)), (bf16*)(ws + (BOFF)), M_PAD, (NN), (KK) / (PP_), (KK)}; pg8::SampOrder S; S.init((NN), (PP_), (KK) / (PP_), F.G, bx); EPI E{__VA_ARGS__}; \
        pg8::gemm_phase<EPI, pg8::SampOrder, true, true, true>(F.lds + RING_OFF, g, S, E); } while (0)
    using EpiRB1 = pg8::EpiResBf<true, 1>; using EpiRB2 = pg8::EpiResBf<false, 2>; using EpiRB3 = pg8::EpiResBf<false, 1>;
    float* const HRp = (float*)(ws + WS_HR); float* const SQ2 = (float*)(ws + WS_SQ2);
#define SMP_NORM(SSQ_, CW_) do { sample_norm_phase(F, HRp, (bf16*)(ws + WS_U), (SSQ_)); if (bx < 16) { __threadfence(); __syncthreads(); \
        if (threadIdx.x == 0) __hip_atomic_fetch_add(F.ctl + (CW_), 1u, __ATOMIC_RELEASE, __HIP_MEMORY_SCOPE_AGENT); } } while (0)
#define SMP_WAIT(CW_, NU_) do { if (bx >= (NU_)) break; if (threadIdx.x == 0) { const unsigned need = F.G < 16 ? (unsigned)F.G : 16u; while (__hip_atomic_load(F.ctl + (CW_), __ATOMIC_ACQUIRE, __HIP_MEMORY_SCOPE_AGENT) < need) __builtin_amdgcn_s_sleep(4); } \
        __syncthreads(); } while (0)
    GEMM_REG(pg8::EpiSwiGLU<false>, WS_U, WS_W1A, 5632, 1024, (bf16*)(ws + WS_H1), DFF, nullptr);
    GEMM_SMP(pg8::EpiSwiGLU<false>, WS_U, WS_W1A, 5632, 1024, 1, (bf16*)(ws + WS_H1), DFF, nullptr);
#define PLE_SLICE(L0_, L1_, WG0_) do { if (bx >= (WG0_)) { pg8::Gemm g{(bf16*)(ws + WS_PB), (bf16*)(ws + WS_WPP), M_PAD, 1024, kple, kple}; pg8::RangeOrder S; S.init((L0_), (L1_), F.G - (WG0_), bx - (WG0_)); \
        pg8::EpiStoreBf16 E{(bf16*)(ws + WS_PP), 1024}; pg8::gemm_phase<pg8::EpiStoreBf16, pg8::RangeOrder, true, true>(F.lds + RING_OFF, g, S, E); } } while (0)
    if (F.G > 48) PLE_SLICE(0, 464, 24); else PLE_SLICE(0, 1028, 0);
    GRID_BAR();
    GEMM_REGV(EpiRB1, WS_H1, WS_W2A, 1024, DFF, args.in[0], (bf16*)(ws + WS_U), SQ2);
    GEMM_SMP(pg8::EpiResidAt, WS_H1, WS_W2A, 1024, DFF, 11, HRp, 0.5f);
    GRID_BAR();
    SMP_NORM(SQ2, CW_NRM);
    GEMM_REG(pg8::EpiWin, WS_U, WS_WIN, NV_IN, 1024, ws, args.in[17], SQ2, (LAS const float*)(F.lds + LDSCTL_OFF));
    SMP_WAIT(CW_NRM, 47);
    GEMM_SMP(pg8::EpiWin, WS_U, WS_WIN, NV_IN, 1024, 1, ws, args.in[17], SQ2, (LAS const float*)(F.lds + LDSCTL_OFF));
    if (F.G > 48) PLE_SLICE(464, 880, 48);
    GRID_BAR();
    mixer_phase_a(F, args);
    GRID_BAR();
    mixer_phase_b(F, args);
    GRID_BAR();
    combine_phase(F, args);
    GRID_BAR();
    GEMM_REGV(pg8::EpiOssm, WS_YG, WS_WOS, 1024, 2048, (bf16*)(ws + WS_T1), (bf16*)(ws + WS_GS), (const float*)(ws + WS_RSTD));
    GEMM_SMP(pg8::EpiOssmAt, WS_YG, WS_WOS, 1024, 2048, 8, (float*)(ws + WS_T1S), (bf16*)(ws + WS_GS), (const float*)(ws + WS_RSTD));
    GRID_BAR();
    GEMM_REG(pg8::EpiMerge<false>, WS_AO, WS_WOA, 1024, 512, (const bf16*)(ws + WS_T1), nullptr, (bf16*)(ws + WS_GA), (bf16*)(ws + WS_MG));
    GEMM_SMP(pg8::EpiMerge<true>, WS_AO, WS_WOA, 1024, 512, 1, nullptr, (const float*)(ws + WS_T1S), (bf16*)(ws + WS_GA), (bf16*)(ws + WS_MG));
    GRID_BAR();
    GEMM_REG(EpiRB2, WS_MG, WS_WOUT, 1024, 1024, nullptr, (bf16*)(ws + WS_U), SQ2 + M_PAD);
    GEMM_SMP(pg8::EpiResidAt, WS_MG, WS_WOUT, 1024, 1024, 4, HRp, 1.0f);
    GRID_BAR();
    SMP_NORM(SQ2 + M_PAD, CW_NRM + 1);
    GEMM_REG(pg8::EpiSwiGLU<true>, WS_U, WS_W1B, 5632, 1024, (bf16*)(ws + WS_H1), DFF, SQ2 + M_PAD);
    SMP_WAIT(CW_NRM + 1, 22);
    GEMM_SMP(pg8::EpiSwiGLU<true>, WS_U, WS_W1B, 5632, 1024, 1, (bf16*)(ws + WS_H1), DFF, SQ2 + M_PAD);
    if (F.G > 48) PLE_SLICE(880, 1028, 24);
    GRID_BAR();
    GEMM_REGV(EpiRB3, WS_H1, WS_W2B, 1024, DFF, nullptr, (bf16*)(ws + WS_U), SQ2 + 2 * M_PAD);
    GEMM_SMP(pg8::EpiResidAt, WS_H1, WS_W2B, 1024, DFF, 11, HRp, 0.5f);
    GRID_BAR();
    SMP_NORM(SQ2 + 2 * M_PAD, CW_NRM + 2);
    GEMM_REG(pg8::EpiPle, WS_U, WS_WPG, 1024, 1024, (bf16*)(ws + WS_U), (bf16*)(ws + WS_PP), SQ2 + 2 * M_PAD, (bf16*)(ws + WS_MG));
    SMP_WAIT(CW_NRM + 2, 4);
    GEMM_SMP(pg8::EpiPle, WS_U, WS_WPG, 1024, 1024, 1, (bf16*)(ws + WS_U), (bf16*)(ws + WS_PP), SQ2 + 2 * M_PAD, (bf16*)(ws + WS_MG));
    GRID_BAR();
    { const int gw = bx * NWAVES + F.wave, NGW = F.G * NWAVES;
      for (int m = gw; m < M_REAL; m += 4 * NGW) { const int left = (M_REAL - 1 - m) / NGW + 1;
          final_rows4((const bf16*)(ws + WS_MG), args.in[31], args.out, (size_t)m, (size_t)NGW, left < 4 ? left : 4, fresh_lane()); } }
}

extern "C" void kernel_launch(void* const* d_in, const int* in_sizes, int n_in, void* d_out, int out_size, void* d_ws, size_t ws_size, hipStream_t stream) {
    static int grid = 0;
    if (grid == 0) {
        if (n_in != 32 || ws_size < WS_END) { fprintf(stderr, "kernel_launch: need 32 inputs and >= %zu bytes of workspace; got n_in %d, ws %zu; nothing launched\n", (size_t)WS_END, n_in, ws_size); grid = -1; return; }
        int dev = 0, cus = 0, per_cu = 0;
        if (hipGetDevice(&dev) != hipSuccess || hipDeviceGetAttribute(&cus, hipDeviceAttributeMultiprocessorCount, dev) != hipSuccess) { grid = -1; return; }
        if (hipFuncSetAttribute((const void*)fwd, hipFuncAttributeMaxDynamicSharedMemorySize, LDS_BYTES) != hipSuccess) { fprintf(stderr, "kernel_launch: hipFuncSetAttribute failed\n"); grid = -1; return; }
        if (hipOccupancyMaxActiveBlocksPerMultiprocessor(&per_cu, (const void*)fwd, NWAVES * 64, LDS_BYTES) != hipSuccess || per_cu < 1)
            fprintf(stderr, "kernel_launch: note: occupancy query reports %d workgroups per CU\n", per_cu);
        (void)hipGetLastError();
        grid = cus;
    }
    if (grid < 0) return;
    if (hipMemsetAsync((char*)d_ws + WS_CTL, 0, CTL_ZERO_BYTES, stream) != hipSuccess) return;
    Args a{};
    for (int i = 0; i < 32; ++i) a.in[i] = (const float*)d_in[i];
    a.out = (float*)d_out; a.ws = (unsigned char*)d_ws;
    hipLaunchKernelGGL(fwd, dim3(grid), dim3(NWAVES * 64), LDS_BYTES, stream, a);
    const hipError_t le = hipPeekAtLastError();
    if (le != hipSuccess) fprintf(stderr, "kernel_launch: launch failed: %s\n", hipGetErrorName(le));
}
```

```cpp
#include <hip/hip_runtime.h>
#include <cstdio>
#include <cstdint>

constexpr int P_ROWS = 65536, S_ROWS = 128, M_REAL = P_ROWS + S_ROWS, M_PAD = 257 * 256, SEQ_T = 8192;
constexpr int NWAVES = 8;
constexpr int DM = 1024, DFF = 2816, DPLE = 256, DINNER = 2048, CONVD = 3072, NHEAD_S = 32, NSTATE = 128, AW = 1536, NV_IN = 47 * 256;
constexpr float EPS = 1e-6f;

constexpr size_t MiB = 1u << 20;
constexpr size_t rup(size_t x) { return (x + MiB - 1) / MiB * MiB; }
constexpr size_t WS_CTL = 0, CTL_ZERO_BYTES = 1 * MiB;
constexpr size_t WS_W1A = 1 * MiB;
constexpr size_t WS_W2A = WS_W1A + rup((size_t)5632 * 1024 * 2);
constexpr size_t WS_WIN = WS_W2A + rup((size_t)1024 * 2816 * 2);
constexpr size_t WS_WOS = WS_WIN + rup((size_t)NV_IN * 1024 * 2);
constexpr size_t WS_WOA = WS_WOS + rup((size_t)1024 * 2048 * 2);
constexpr size_t WS_WOUT = WS_WOA + rup((size_t)1024 * 512 * 2);
constexpr size_t WS_W1B = WS_WOUT + rup((size_t)1024 * 1024 * 2);
constexpr size_t WS_W2B = WS_W1B + rup((size_t)5632 * 1024 * 2);
constexpr size_t WS_WPG = WS_W2B + rup((size_t)1024 * 2816 * 2);
constexpr size_t WS_WPP = WS_WPG + rup((size_t)1024 * 1024 * 2);
constexpr size_t WS_CS = WS_WPP + rup((size_t)1024 * 256 * 2);
constexpr size_t WS_U = WS_CS + rup((size_t)8193 * 32 * 8);
constexpr size_t WS_H1 = WS_U + rup((size_t)M_PAD * 1024 * 2);
constexpr size_t WS_HR = WS_H1 + rup((size_t)M_PAD * 2816 * 2);
constexpr size_t WS_PB = WS_HR + rup((size_t)M_PAD * 1024 * 4);
constexpr size_t WS_PP = WS_PB + rup((size_t)M_PAD * 256 * 2);
constexpr size_t WS_Z = WS_PP + rup((size_t)M_PAD * 1024 * 2);
constexpr size_t WS_XBC = WS_Z + rup((size_t)M_PAD * 2048 * 2);
constexpr size_t WS_Q = WS_XBC + rup((size_t)M_PAD * 3072 * 2);
constexpr size_t WS_K = WS_Q + rup((size_t)M_PAD * 1536 * 2);
constexpr size_t WS_V = WS_K + rup((size_t)M_PAD * 1536 * 2);
constexpr size_t WS_GS = WS_V + rup((size_t)M_PAD * 1536 * 2);
constexpr size_t WS_GA = WS_GS + rup((size_t)M_PAD * 1024 * 2);
constexpr size_t WS_DT = WS_GA + rup((size_t)M_PAD * 1024 * 2);
constexpr size_t WS_YG = WS_DT + rup((size_t)M_PAD * 32 * 4);
constexpr size_t WS_SSQ = WS_YG + rup((size_t)M_PAD * 2048 * 2);
constexpr size_t WS_RSTD = WS_SSQ + rup((size_t)M_PAD * 64 * 4);
constexpr size_t WS_AOG = WS_RSTD + rup((size_t)M_PAD * 4);
constexpr size_t AOG_STRIDE = (size_t)M_PAD * 512;
constexpr size_t WS_LSE = WS_AOG + rup(3 * AOG_STRIDE * 2);
constexpr size_t LSE_STRIDE = (size_t)M_PAD * 8;
constexpr size_t WS_AO = WS_LSE + rup(3 * LSE_STRIDE * 4);
constexpr size_t WS_T1 = WS_AO + rup((size_t)M_PAD * 512 * 2);
constexpr size_t WS_MG = WS_T1 + rup((size_t)M_PAD * 1024 * 4);
constexpr size_t WS_QS = WS_MG + rup((size_t)M_PAD * 1024 * 2);
constexpr size_t WS_XC = WS_QS + rup((size_t)128 * 24 * 64 * 4);
constexpr size_t WS_SQ2 = WS_XC + rup((size_t)65536 * 3072 * 2);
constexpr size_t WS_T1S = WS_SQ2 + rup((size_t)3 * M_PAD * 4);
constexpr size_t WS_END = WS_T1S + rup((size_t)256 * 1024 * 4);
constexpr int CW_TMO = 0, CW_CODE = 1, CW_NRM = 64, CW_BAR = 4096;

namespace pg8 {
#define PG8_LAS __attribute__((address_space(3)))
typedef unsigned short bf16_t;
typedef short bf16x8 __attribute__((ext_vector_type(8)));
typedef float f32x4 __attribute__((ext_vector_type(4)));
typedef unsigned u32x4 __attribute__((ext_vector_type(4)));
constexpr int BM = 256, BK = 64, HALF = 128, HTB = HALF * BK * 2  , STAGE_BYTES = 8 * HTB, NXCD = 8, WGM = 8;

__host__ __device__ __forceinline__ int lds_byte(int r, int c) { const int st = (r >> 4) * 2 + (c >> 5), rr = r & 15, cc = c & 31, ob = rr * 64 + cc * 2; return st * 1024 + (ob ^ (((ob >> 9) & 1) << 5)); }
__host__ __device__ __forceinline__ void stage_rc(int b, int& R, int& C) { const int st = b / 1024, sb = b % 1024, swz = sb ^ (((sb >> 9) & 1) << 5); R = (st >> 1) * 16 + swz / 64; C = (st & 1) * 32 + (swz % 64) / 2; }
__host__ __device__ __forceinline__ int perm32(int rho) { const int n = rho >> 4, i = rho & 15; return 8 * (i >> 2) + 4 * n + (i & 3); }

struct Unit { int pm, pn, ko; };
struct Gemm { const bf16_t* A; const bf16_t* Bt; int M, N, K, ld; };

struct StaticOrder {
    int nM, nN, nwg, G, c, rev;
    __host__ __device__ void init(int M, int N, int G_, int c_, int rev_ = 0) { nM = M / BM; nN = N / BM; nwg = nM * nN; G = G_; c = c_; rev = rev_; }
    __host__ __device__ bool next(int i, Unit& u) const {
        const long L = (long)i * G + c; if (L >= nwg) return false;
        int wgid = (int)L; { const int q = nwg / NXCD, r = nwg % NXCD, xcd = wgid % NXCD, off = wgid / NXCD; wgid = (xcd < r ? xcd * (q + 1) : r * (q + 1) + (xcd - r) * q) + off; }
        const int nig = WGM * nN, gid = wgid / nig, fm = gid * WGM, gsz = (nM - fm) < WGM ? (nM - fm) : WGM;
        const int pm = fm + ((wgid % nig) % gsz); u.pm = rev ? nM - 1 - pm : pm; u.pn = (wgid % nig) / gsz; u.ko = 0; return true;
    }
    __device__ __forceinline__ void a_ready(const Unit&) const {}
    __device__ __forceinline__ void done(const Unit&) const {}
};

struct SampOrder {
    int nN, P, Kp, G, c;
    __device__ __forceinline__ void init(int N, int P_, int Kp_, int G_, int c_) { nN = N / BM; P = P_; Kp = Kp_; G = G_; c = c_; }
    __device__ __forceinline__ bool next(int i, Unit& u) const { const long L = (long)i * G + c; if (L >= (long)nN * P) return false;
        int pm = 256; asm volatile("" : "+s"(pm));
        u.pm = pm; u.pn = (int)(L % nN); u.ko = (int)(L / nN) * Kp; return true; }
    __device__ __forceinline__ void a_ready(const Unit&) const {}
    __device__ __forceinline__ void done(const Unit&) const {}
};

struct RangeOrder {
    int L0, L1, G, c;
    __device__ __forceinline__ void init(int L0_, int L1_, int G_, int c_) { L0 = L0_; L1 = L1_; G = G_; c = c_; }
    __device__ __forceinline__ bool next(int i, Unit& u) const { const int L = L0 + i * G + c; if (L >= L1) return false; u.pm = L >> 2; u.pn = L & 3; u.ko = 0; return true; }
    __device__ __forceinline__ void a_ready(const Unit&) const {}
    __device__ __forceinline__ void done(const Unit&) const {}
};

__device__ __forceinline__ unsigned cvt_pk_bf16(float lo, float hi) { unsigned r; asm volatile("v_cvt_pk_bf16_f32 %0, %1, %2" : "=v"(r) : "v"(lo), "v"(hi)); return r; }

constexpr float C2Q = 0.125f * 1.4426950408889634f;
typedef float f32x2e __attribute__((ext_vector_type(2)));
typedef unsigned u32x2e __attribute__((ext_vector_type(2)));

__device__ __forceinline__ float ex2(float x) { return __builtin_amdgcn_exp2f(x); }
__device__ __forceinline__ float sigm(float x) { return __builtin_amdgcn_rcpf(1.0f + ex2(-1.4426950408889634f * x)); }
__device__ __forceinline__ float silu_f(float x) { return x * sigm(x); }
__device__ __forceinline__ float softplus_f(float x) { return x > 20.f ? x : 0.6931471805599453f * __builtin_amdgcn_logf(1.0f + ex2(1.4426950408889634f * x)); }
__device__ __forceinline__ u32x4 pack8(const f32x4 a, const f32x4 b) { u32x4 w; w.x = cvt_pk_bf16(a[0], a[1]); w.y = cvt_pk_bf16(a[2], a[3]); w.z = cvt_pk_bf16(b[0], b[1]); w.w = cvt_pk_bf16(b[2], b[3]); return w; }
__device__ __forceinline__ float bf_lo(unsigned w) { return __builtin_bit_cast(float, w << 16); }
__device__ __forceinline__ float bf_hi(unsigned w) { return __builtin_bit_cast(float, w & 0xffff0000u); }

template <bool RS> struct EpiSwiGLU {
    static constexpr bool PERM = true, AFTER_DRAIN = false;
    bf16_t* O; int ldc; const float* ssq;
    __device__ __forceinline__ void operator()(const f32x4 (&acc)[2][2][4][2], const Unit& u, int wr, int wc, int fr, int fq) const {
        const int row0 = u.pm * BM + wr * 64 + fr, col0 = u.pn * HALF + wc * 32 + 8 * fq;
        float rsv[2][4];
#pragma unroll
        for (int ai = 0; ai < 2; ++ai)
#pragma unroll
            for (int m = 0; m < 4; ++m) rsv[ai][m] = RS ? ssq[row0 + ai * HALF + m * 16] : 0.f;
#pragma unroll
        for (int ai = 0; ai < 2; ++ai)
#pragma unroll
            for (int m = 0; m < 4; ++m) {
                const int row = row0 + ai * HALF + m * 16;
                bf16_t* rowp = O + (size_t)row * ldc + col0;
                const float rs = RS ? __builtin_amdgcn_rsqf(rsv[ai][m] * (1.f / 1024.f) + 1e-6f) : 1.0f;
                f32x4 v0, v1;
#pragma unroll
                for (int j = 0; j < 4; ++j) { v0[j] = silu_f(acc[ai][0][m][0][j] * rs) * (acc[ai][1][m][0][j] * rs); v1[j] = silu_f(acc[ai][0][m][1][j] * rs) * (acc[ai][1][m][1][j] * rs); }
                *(u32x4*)rowp = pack8(v0, v1);
            }
    }
};

template <int MODE, bool NORM> struct EpiResid {
    static constexpr bool PERM = false, AFTER_DRAIN = false;
    const float* R0; const float* R1; float* O; float scale; const bf16_t* PP; const float* ssq_in; bf16_t* HB; float* ssq_out;
    __device__ __forceinline__ void operator()(const f32x4 (&acc)[2][2][4][2], const Unit& u, int wr, int wc, int fr, int fq) const {
        const int col0 = u.pn * BM + wc * 32 + 4 * fq;
        constexpr int MB = MODE == 1 ? 2 : 4;
#pragma unroll
        for (int ab = 0; ab < 8 / MB; ++ab) {
            const int ai = (ab * MB) >> 2, m0 = (ab * MB) & 3;
            f32x4 rv[MB][2][2]; u32x2e pw[MB][2][2]; float rsi[MB];
#pragma unroll
            for (int mm = 0; mm < MB; ++mm) { const int m = mm;
                const int row = u.pm * BM + ai * HALF + wr * 64 + (m0 + mm) * 16 + fr;
                const float* rp = row < P_ROWS ? R0 + (size_t)row * 1024 : R1 + (size_t)(row - P_ROWS) * 1024;
                const bool live = row < M_REAL;
                rsi[m] = MODE == 1 ? ssq_in[row] : 0.f;
#pragma unroll
                for (int bj = 0; bj < 2; ++bj)
#pragma unroll
                    for (int n = 0; n < 2; ++n) { const int c = col0 + bj * HALF + n * 16;
                        rv[m][bj][n] = live ? *(const f32x4*)(rp + c) : (f32x4){0.f, 0.f, 0.f, 0.f};
                        if (MODE == 1) pw[m][bj][n] = *(const u32x2e*)(PP + (size_t)row * 1024 + c); }
            }
#pragma unroll
            for (int mm = 0; mm < MB; ++mm) { const int m = mm;
                const int row = u.pm * BM + ai * HALF + wr * 64 + (m0 + mm) * 16 + fr;
                const float rs1 = MODE == 1 ? __builtin_amdgcn_rsqf(rsi[m] * (1.f / 1024.f) + 1e-6f) : 1.0f;
                float sq = 0.f;
#pragma unroll
                for (int bj = 0; bj < 2; ++bj)
#pragma unroll
                    for (int n = 0; n < 2; ++n) {
                        const int c = col0 + bj * HALF + n * 16;
                        f32x4 r = rv[m][bj][n];
                        const f32x4 a = acc[ai][bj][m0 + mm][n];
                        if (MODE == 0) r = r + a * scale;
                        else { const u32x2e p2 = pw[m][bj][n];
                               r[0] += sigm(a[0] * rs1) * bf_lo(p2.x); r[1] += sigm(a[1] * rs1) * bf_hi(p2.x); r[2] += sigm(a[2] * rs1) * bf_lo(p2.y); r[3] += sigm(a[3] * rs1) * bf_hi(p2.y); }
                        *(f32x4*)(O + (size_t)row * 1024 + c) = r;
                        if (NORM) { u32x2e hw; hw.x = cvt_pk_bf16(r[0], r[1]); hw.y = cvt_pk_bf16(r[2], r[3]); *(u32x2e*)(HB + (size_t)row * 1024 + c) = hw;
                                    sq += (r[0] * r[0] + r[1] * r[1]) + (r[2] * r[2] + r[3] * r[3]); }
                    }
                if (NORM) { sq += __shfl_xor(sq, 16); sq += __shfl_xor(sq, 32);
                            if (fq == 0) __hip_atomic_fetch_add(ssq_out + row, sq, __ATOMIC_RELAXED, __HIP_MEMORY_SCOPE_AGENT); }
            }
        }
    }
};
template <bool SRC_F32, int SCALE2  > struct EpiResBf {
    static constexpr bool PERM = true, AFTER_DRAIN = false;
    const float* R0; bf16_t* HB; float* ssq_out;
    __device__ __forceinline__ void operator()(const f32x4 (&acc)[2][2][4][2], const Unit& u, int wr, int wc, int fr, int fq) const {
        const int row0 = u.pm * BM + wr * 64 + fr, col0 = u.pn * BM + wc * 32 + 8 * fq;
        constexpr float scale = 0.5f * SCALE2;
#pragma unroll
        for (int ai = 0; ai < 2; ++ai) {
            f32x4 rf[4][2][2]; u32x4 rb[4][2];
#pragma unroll
            for (int m = 0; m < 4; ++m)
#pragma unroll
                for (int bj = 0; bj < 2; ++bj) { const size_t o = (size_t)(row0 + ai * HALF + m * 16) * 1024 + col0 + bj * HALF;
                    if constexpr (SRC_F32) { rf[m][bj][0] = *(const f32x4*)(R0 + o); rf[m][bj][1] = *(const f32x4*)(R0 + o + 4); rb[m][bj] = (u32x4){0u, 0u, 0u, 0u}; }
                    else { rb[m][bj] = *(const u32x4*)(HB + o); rf[m][bj][0] = (f32x4){0.f, 0.f, 0.f, 0.f}; rf[m][bj][1] = rf[m][bj][0]; } }
#pragma unroll
            for (int m = 0; m < 4; ++m) {
                const int row = row0 + ai * HALF + m * 16;
                float sq = 0.f;
#pragma unroll
                for (int bj = 0; bj < 2; ++bj) {
                    const size_t o = (size_t)row * 1024 + col0 + bj * HALF;
                    f32x4 r0, r1;
                    if constexpr (SRC_F32) { r0 = rf[m][bj][0]; r1 = rf[m][bj][1]; }
                    else { const u32x4 w = rb[m][bj]; r0 = (f32x4){bf_lo(w.x), bf_hi(w.x), bf_lo(w.y), bf_hi(w.y)}; r1 = (f32x4){bf_lo(w.z), bf_hi(w.z), bf_lo(w.w), bf_hi(w.w)}; }
                    r0 = r0 + acc[ai][bj][m][0] * scale; r1 = r1 + acc[ai][bj][m][1] * scale;
                    *(u32x4*)(HB + o) = pack8(r0, r1);
                    sq += ((r0[0] * r0[0] + r0[1] * r0[1]) + (r0[2] * r0[2] + r0[3] * r0[3])) + ((r1[0] * r1[0] + r1[1] * r1[1]) + (r1[2] * r1[2] + r1[3] * r1[3]));
                }
                sq += __shfl_xor(sq, 16); sq += __shfl_xor(sq, 32);
                if (fq == 0) __hip_atomic_fetch_add(ssq_out + row, sq, __ATOMIC_RELAXED, __HIP_MEMORY_SCOPE_AGENT);
            }
        }
    }
};
struct EpiPle {
    static constexpr bool PERM = true, AFTER_DRAIN = false;
    const bf16_t* HB; const bf16_t* PP; const float* ssq_in; bf16_t* OUT;
    __device__ __forceinline__ void operator()(const f32x4 (&acc)[2][2][4][2], const Unit& u, int wr, int wc, int fr, int fq) const {
        const int row0 = u.pm * BM + wr * 64 + fr, col0 = u.pn * BM + wc * 32 + 8 * fq;
#pragma unroll
        for (int ai = 0; ai < 2; ++ai) {
            u32x4 hv[4][2], pw[4][2]; float rsi[4];
#pragma unroll
            for (int m = 0; m < 4; ++m) { const int row = row0 + ai * HALF + m * 16; rsi[m] = ssq_in[row];
#pragma unroll
                for (int bj = 0; bj < 2; ++bj) { const size_t o = (size_t)row * 1024 + col0 + bj * HALF; hv[m][bj] = *(const u32x4*)(HB + o); pw[m][bj] = *(const u32x4*)(PP + o); } }
#pragma unroll
            for (int m = 0; m < 4; ++m) {
                const int row = row0 + ai * HALF + m * 16;
                const float rs1 = __builtin_amdgcn_rsqf(rsi[m] * (1.f / 1024.f) + 1e-6f);
#pragma unroll
                for (int bj = 0; bj < 2; ++bj) { const f32x4 a0 = acc[ai][bj][m][0], a1 = acc[ai][bj][m][1]; const u32x4 h4 = hv[m][bj], p4 = pw[m][bj];
                    f32x4 r0, r1;
                    r0[0] = bf_lo(h4.x) + sigm(a0[0] * rs1) * bf_lo(p4.x); r0[1] = bf_hi(h4.x) + sigm(a0[1] * rs1) * bf_hi(p4.x); r0[2] = bf_lo(h4.y) + sigm(a0[2] * rs1) * bf_lo(p4.y); r0[3] = bf_hi(h4.y) + sigm(a0[3] * rs1) * bf_hi(p4.y);
                    r1[0] = bf_lo(h4.z) + sigm(a1[0] * rs1) * bf_lo(p4.z); r1[1] = bf_hi(h4.z) + sigm(a1[1] * rs1) * bf_hi(p4.z); r1[2] = bf_lo(h4.w) + sigm(a1[2] * rs1) * bf_lo(p4.w); r1[3] = bf_hi(h4.w) + sigm(a1[3] * rs1) * bf_hi(p4.w);
                    *(u32x4*)(OUT + (size_t)row * 1024 + col0 + bj * HALF) = pack8(r0, r1); }
            }
        }
    }
};
struct EpiResidAt {
    static constexpr bool PERM = false, AFTER_DRAIN = false;
    float* O; float scale;
    __device__ __forceinline__ void operator()(const f32x4 (&acc)[2][2][4][2], const Unit& u, int wr, int wc, int fr, int fq) const {
        const int col0 = u.pn * BM + wc * 32 + 4 * fq;
#pragma unroll
        for (int m = 0; m < 4; ++m) {
            const int row = u.pm * BM + wr * 64 + m * 16 + fr;
#pragma unroll
            for (int bj = 0; bj < 2; ++bj)
#pragma unroll
                for (int n = 0; n < 2; ++n) { float* p = O + (size_t)row * 1024 + col0 + bj * HALF + n * 16; const f32x4 a = acc[0][bj][m][n];
#pragma unroll
                    for (int j = 0; j < 4; ++j) __hip_atomic_fetch_add(p + j, a[j] * scale, __ATOMIC_RELAXED, __HIP_MEMORY_SCOPE_AGENT); }
        }
    }
};

struct EpiStoreBf16 {
    static constexpr bool PERM = true, AFTER_DRAIN = false;
    bf16_t* O; int ldc;
    __device__ __forceinline__ void operator()(const f32x4 (&acc)[2][2][4][2], const Unit& u, int wr, int wc, int fr, int fq) const {
        const int row0 = u.pm * BM + wr * 64 + fr, col0 = u.pn * BM + wc * 32 + 8 * fq;
#pragma unroll
        for (int ai = 0; ai < 2; ++ai)
#pragma unroll
            for (int m = 0; m < 4; ++m) { bf16_t* rowp = O + (size_t)(row0 + ai * HALF + m * 16) * ldc + col0;
#pragma unroll
                for (int bj = 0; bj < 2; ++bj) *(u32x4*)(rowp + bj * HALF) = pack8(acc[ai][bj][m][0], acc[ai][bj][m][1]); }
    }
};

struct EpiOssm {
    static constexpr bool PERM = true, AFTER_DRAIN = false;
    bf16_t* T1; const bf16_t* GS; const float* rstd;
    __device__ __forceinline__ void operator()(const f32x4 (&acc)[2][2][4][2], const Unit& u, int wr, int wc, int fr, int fq) const {
        const int row0 = u.pm * BM + wr * 64 + fr, col0 = u.pn * BM + wc * 32 + 8 * fq;
#pragma unroll
        for (int ai = 0; ai < 2; ++ai) {
            u32x4 gw[4][2]; float rsv[4];
#pragma unroll
            for (int m = 0; m < 4; ++m) { const int row = row0 + ai * HALF + m * 16; rsv[m] = rstd[row];
#pragma unroll
                for (int bj = 0; bj < 2; ++bj) gw[m][bj] = *(const u32x4*)(GS + (size_t)row * 1024 + col0 + bj * HALF); }
#pragma unroll
            for (int m = 0; m < 4; ++m) {
                const int row = row0 + ai * HALF + m * 16; const float rs = rsv[m];
#pragma unroll
                for (int bj = 0; bj < 2; ++bj) {
                    const u32x4 g4 = gw[m][bj]; const f32x4 a0 = acc[ai][bj][m][0], a1 = acc[ai][bj][m][1];
                    f32x4 r0, r1;
                    r0[0] = a0[0] * rs * bf_lo(g4.x); r0[1] = a0[1] * rs * bf_hi(g4.x); r0[2] = a0[2] * rs * bf_lo(g4.y); r0[3] = a0[3] * rs * bf_hi(g4.y);
                    r1[0] = a1[0] * rs * bf_lo(g4.z); r1[1] = a1[1] * rs * bf_hi(g4.z); r1[2] = a1[2] * rs * bf_lo(g4.w); r1[3] = a1[3] * rs * bf_hi(g4.w);
                    *(u32x4*)(T1 + (size_t)row * 1024 + col0 + bj * HALF) = pack8(r0, r1);
                }
            }
        }
    }
};

struct EpiOssmAt {
    static constexpr bool PERM = false, AFTER_DRAIN = false;
    float* T1; const bf16_t* GS; const float* rstd;
    __device__ __forceinline__ void operator()(const f32x4 (&acc)[2][2][4][2], const Unit& u, int wr, int wc, int fr, int fq) const {
        const int col0 = u.pn * BM + wc * 32 + 4 * fq;
#pragma unroll
        for (int m = 0; m < 4; ++m) {
            const int row = u.pm * BM + wr * 64 + m * 16 + fr;
            const float rs = rstd[row];
#pragma unroll
            for (int bj = 0; bj < 2; ++bj)
#pragma unroll
                for (int n = 0; n < 2; ++n) {
                    const int c = col0 + bj * HALF + n * 16;
                    const u32x2e gw = *(const u32x2e*)(GS + (size_t)row * 1024 + c);
                    const f32x4 a = acc[0][bj][m][n]; float* p = T1 + (size_t)(row - P_ROWS) * 1024 + c;
                    __hip_atomic_fetch_add(p + 0, a[0] * rs * bf_lo(gw.x), __ATOMIC_RELAXED, __HIP_MEMORY_SCOPE_AGENT); __hip_atomic_fetch_add(p + 1, a[1] * rs * bf_hi(gw.x), __ATOMIC_RELAXED, __HIP_MEMORY_SCOPE_AGENT);
                    __hip_atomic_fetch_add(p + 2, a[2] * rs * bf_lo(gw.y), __ATOMIC_RELAXED, __HIP_MEMORY_SCOPE_AGENT); __hip_atomic_fetch_add(p + 3, a[3] * rs * bf_hi(gw.y), __ATOMIC_RELAXED, __HIP_MEMORY_SCOPE_AGENT);
                }
        }
    }
};

template <bool SMP> struct EpiMerge {
    static constexpr bool PERM = true, AFTER_DRAIN = false;
    const bf16_t* T1; const float* T1S; const bf16_t* GA; bf16_t* O;
    __device__ __forceinline__ void operator()(const f32x4 (&acc)[2][2][4][2], const Unit& u, int wr, int wc, int fr, int fq) const {
        const int row0 = u.pm * BM + wr * 64 + fr, col0 = u.pn * BM + wc * 32 + 8 * fq;
#pragma unroll
        for (int ab = 0; ab < 4; ++ab) {
            const int ai = ab >> 1, m0 = (ab & 1) * 2;
            u32x4 gw[2][2], tb[2][2]; f32x4 t0[2][2], t1[2][2];
#pragma unroll
            for (int m = 0; m < 2; ++m)
#pragma unroll
                for (int bj = 0; bj < 2; ++bj) { const int row = row0 + ai * HALF + (m0 + m) * 16; const size_t o = (size_t)row * 1024 + col0 + bj * HALF;
                    gw[m][bj] = *(const u32x4*)(GA + o);
                    if constexpr (SMP) { const size_t os = (size_t)(row - P_ROWS) * 1024 + col0 + bj * HALF; t0[m][bj] = *(const f32x4*)(T1S + os); t1[m][bj] = *(const f32x4*)(T1S + os + 4); tb[m][bj] = (u32x4){0u, 0u, 0u, 0u}; }
                    else { tb[m][bj] = *(const u32x4*)(T1 + o); t0[m][bj] = (f32x4){0.f, 0.f, 0.f, 0.f}; t1[m][bj] = t0[m][bj]; } }
#pragma unroll
            for (int m = 0; m < 2; ++m)
#pragma unroll
                for (int bj = 0; bj < 2; ++bj) {
                    const size_t o = (size_t)(row0 + ai * HALF + (m0 + m) * 16) * 1024 + col0 + bj * HALF;
                    const u32x4 g4 = gw[m][bj]; const f32x4 a0 = acc[ai][bj][m0 + m][0], a1 = acc[ai][bj][m0 + m][1];
                    f32x4 x0, x1;
                    if constexpr (SMP) { x0 = t0[m][bj]; x1 = t1[m][bj]; }
                    else { const u32x4 w = tb[m][bj]; x0 = (f32x4){bf_lo(w.x), bf_hi(w.x), bf_lo(w.y), bf_hi(w.y)}; x1 = (f32x4){bf_lo(w.z), bf_hi(w.z), bf_lo(w.w), bf_hi(w.w)}; }
                    f32x4 r0, r1;
                    r0[0] = x0[0] + bf_lo(g4.x) * a0[0]; r0[1] = x0[1] + bf_hi(g4.x) * a0[1]; r0[2] = x0[2] + bf_lo(g4.y) * a0[2]; r0[3] = x0[3] + bf_hi(g4.y) * a0[3];
                    r1[0] = x1[0] + bf_lo(g4.z) * a1[0]; r1[1] = x1[1] + bf_hi(g4.z) * a1[1]; r1[2] = x1[2] + bf_lo(g4.w) * a1[2]; r1[3] = x1[3] + bf_hi(g4.w) * a1[3];
                    *(u32x4*)(O + o) = pack8(r0, r1);
                }
        }
    }
};

struct EpiWin {
    static constexpr bool PERM = true, AFTER_DRAIN = false;
    unsigned char* ws; const float* dtb; const float* ssq; PG8_LAS const float* ifq;
    static constexpr size_t O_KVP0 = 67108864ull + 131072ull, O_KVP1 = O_KVP0 + 1048576ull, O_KVP2 = O_KVP1 + 4194304ull, O_CONVP = O_KVP2 + 16777216ull, O_SSMP = O_CONVP + 73728ull,
                            O_KVS0 = O_SSMP + 2097152ull, O_KVS1 = O_KVS0 + 131072ull, O_KVS2 = O_KVS1 + 131072ull, O_CONVS = O_KVS2 + 131072ull, O_SSMS = O_CONVS + 1179648ull;
    __device__ __forceinline__ void operator()(const f32x4 (&acc)[2][2][4][2], const Unit& u, int wr, int wc, int fr, int fq) const {
        const int pn = u.pn;
        const int cl = wc * 32 + 8 * fq;
        if (pn < 46) {
            size_t boff; int ldc, ct;
            if (pn < 8) { boff = WS_Z; ldc = 2048; ct = pn; } else if (pn < 20) { boff = WS_XBC; ldc = 3072; ct = pn - 8; }
            else if (pn < 26) { boff = WS_Q; ldc = 1536; ct = pn - 20; } else if (pn < 32) { boff = WS_K; ldc = 1536; ct = pn - 26; } else if (pn < 38) { boff = WS_V; ldc = 1536; ct = pn - 32; }
            else if (pn < 42) { boff = WS_GS; ldc = 1024; ct = pn - 38; } else { boff = WS_GA; ldc = 1024; ct = pn - 42; }
            const bool rot = pn >= 20 && pn < 32, sg = pn >= 38;
            const float sc = pn < 26 ? C2Q : 1.0f;
            bf16_t* base = (bf16_t*)(ws + boff) + ct * BM + cl;
            float rsv[2][4];
#pragma unroll
            for (int ai = 0; ai < 2; ++ai)
#pragma unroll
                for (int m = 0; m < 4; ++m) rsv[ai][m] = ssq[u.pm * BM + ai * HALF + wr * 64 + m * 16 + fr];
            f32x4 fr4 = (f32x4){0.f, 0.f, 0.f, 0.f};
            if (rot) fr4 = *(PG8_LAS const f32x4*)(ifq + ((cl & 63) >> 1));
#pragma unroll
            for (int ai = 0; ai < 2; ++ai)
#pragma unroll
                for (int m = 0; m < 4; ++m) {
                    const int row = u.pm * BM + ai * HALF + wr * 64 + m * 16 + fr;
                    const float rs = __builtin_amdgcn_rsqf(rsv[ai][m] * (1.f / 1024.f) + 1e-6f);
                    f32x4 cs0 = (f32x4){1.f, 0.f, 1.f, 0.f}, cs1 = cs0;
                    if (rot) {
                        const float posf = (float)(row < P_ROWS ? (row & (SEQ_T - 1)) : SEQ_T);
                        float cc[4], sn[4];
#pragma unroll
                        for (int e = 0; e < 4; ++e) { const float ang = posf * fr4[e];
                            const float k = __builtin_rintf(ang * 0.15915494309189535f);
                            float r = __builtin_fmaf(-k, 6.2831855f, ang); r = __builtin_fmaf(-k, -1.7484555e-7f, r);
                            const float t = r * 0.15915494309189535f; cc[e] = __builtin_amdgcn_cosf(t); sn[e] = __builtin_amdgcn_sinf(t); }
                        cs0 = (f32x4){cc[0], sn[0], cc[1], sn[1]}; cs1 = (f32x4){cc[2], sn[2], cc[3], sn[3]};
                    }
#pragma unroll
                    for (int bj = 0; bj < 2; ++bj) {
                        f32x4 a0 = acc[ai][bj][m][0] * rs, a1 = acc[ai][bj][m][1] * rs;
                        if (sg) {
#pragma unroll
                            for (int j = 0; j < 4; ++j) { a0[j] = sigm(a0[j]); a1[j] = sigm(a1[j]); } }
                        if (rot) {
                            f32x4 w0, w1;
                            w0[0] = (a0[0] * cs0[0] - a0[1] * cs0[1]) * sc; w0[1] = (a0[1] * cs0[0] + a0[0] * cs0[1]) * sc;
                            w0[2] = (a0[2] * cs0[2] - a0[3] * cs0[3]) * sc; w0[3] = (a0[3] * cs0[2] + a0[2] * cs0[3]) * sc;
                            w1[0] = (a1[0] * cs1[0] - a1[1] * cs1[1]) * sc; w1[1] = (a1[1] * cs1[0] + a1[0] * cs1[1]) * sc;
                            w1[2] = (a1[2] * cs1[2] - a1[3] * cs1[3]) * sc; w1[3] = (a1[3] * cs1[2] + a1[2] * cs1[3]) * sc;
                            a0 = w0; a1 = w1;
                        }
                        *(u32x4*)(base + (size_t)row * ldc + bj * HALF) = pack8(a0, a1);
                    }
                }
        } else {
            if (wc == 0) {
                const int c0 = 8 * fq; float* DT = (float*)(ws + WS_DT);
                const f32x4 b0 = *(const f32x4*)(dtb + c0), b1 = *(const f32x4*)(dtb + c0 + 4);
#pragma unroll
                for (int ai = 0; ai < 2; ++ai)
#pragma unroll
                    for (int m = 0; m < 4; ++m) {
                        const int row = u.pm * BM + ai * HALF + wr * 64 + m * 16 + fr;
                        const float rs = __builtin_amdgcn_rsqf(ssq[row] * (1.f / 1024.f) + 1e-6f);
                        f32x4 a0 = acc[ai][0][m][0] * rs + b0, a1 = acc[ai][0][m][1] * rs + b1;
#pragma unroll
                        for (int j = 0; j < 4; ++j) { a0[j] = softplus_f(a0[j]); a1[j] = softplus_f(a1[j]); }
                        *(f32x4*)(DT + (size_t)row * 32 + c0) = a0; *(f32x4*)(DT + (size_t)row * 32 + c0 + 4) = a1;
                    }
            }
        }
    }
};

template <class Epi, class Sched, bool ALIGN_EPI = false, bool SP2 = false, bool HALFM = false>
__device__ __forceinline__ void gemm_phase(PG8_LAS unsigned char* lds, const Gemm g, const Sched& S, const Epi& E) {
    int tid_ = threadIdx.x; asm volatile("" : "+v"(tid_));
    const int tid = tid_, wid = __builtin_amdgcn_readfirstlane(tid >> 6), lane = tid & 63, wr = wid >> 2, wc = wid & 3, fr = lane & 15, fq = lane >> 4;
    const int K = g.K, nt = K / BK;
    unsigned voffA[2], voffB[2];
#pragma unroll
    for (int i = 0; i < 2; ++i) { int R, C; stage_rc(tid * 16 + i * 8192, R, C); const int Rb = Epi::PERM ? ((R & ~31) + perm32(R & 31)) : R;
        voffA[i] = (unsigned)(R * g.ld + C) * 2u; voffB[i] = (unsigned)(Rb * g.ld + C) * 2u; }
    const size_t kstep = (size_t)(BK * 2);
    const size_t hstep = (size_t)HALF * g.ld * 2;
    const size_t tstep = 2 * hstep;
    const unsigned ldsw = (unsigned)wid * 1024u;
    const int aoff = lds_byte(wr * 64 + fr, fq * 8), boff = lds_byte(wc * 32 + fr, fq * 8);
#define PG8_SA(b, h) (((b) * 2 + (h)) * HTB)
#define PG8_SB(b, h) ((4 + (b) * 2 + (h)) * HTB)
#define PG8_STAGE(bufoff, gbase, voff) do { _Pragma("unroll") for (int _i = 0; _i < 2; ++_i) \
        __builtin_amdgcn_global_load_lds((const unsigned*)((const char*)(gbase) + (voff)[_i]), (PG8_LAS unsigned*)(lds + (bufoff) + ldsw + _i * 8192), 16, 0, 0); } while (0)
#define PG8_LDA(dst, b, h) do { _Pragma("unroll") for (int m = 0; m < 4; ++m) _Pragma("unroll") for (int k = 0; k < 2; ++k) dst[m][k] = *(const PG8_LAS bf16x8*)(lds + PG8_SA(b, h) + aoff + m * 2048 + k * 1024); } while (0)
#define PG8_LDB(dst, b, h) do { _Pragma("unroll") for (int n = 0; n < 2; ++n) _Pragma("unroll") for (int k = 0; k < 2; ++k) dst[n][k] = *(const PG8_LAS bf16x8*)(lds + PG8_SB(b, h) + boff + n * 2048 + k * 1024); } while (0)
#define PG8_MMA(ai, bj, At, Bt) do { __builtin_amdgcn_s_setprio(1); _Pragma("unroll") for (int m = 0; m < 4; ++m) _Pragma("unroll") for (int n = 0; n < 2; ++n) _Pragma("unroll") for (int k = 0; k < 2; ++k) \
        acc[ai][bj][m][n] = __builtin_amdgcn_mfma_f32_16x16x32_bf16(Bt[n][k], At[m][k], acc[ai][bj][m][n], 0, 0, 0); __builtin_amdgcn_s_setprio(0); } while (0)
#define PG8_WAIT_V(n) asm volatile("s_waitcnt vmcnt(" #n ")" ::: "memory")
#define PG8_WAIT_L(n) asm volatile("s_waitcnt lgkmcnt(" #n ")" ::: "memory")
#define PG8_BAR __builtin_amdgcn_s_barrier()
#define PG8_SCHED __builtin_amdgcn_sched_barrier(0)
    Unit cur, nxt; int ui = 0;
    if (!S.next(0, cur)) return;
    f32x4 acc[2][2][4][2];
#pragma unroll
    for (int a = 0; a < 2; ++a)
#pragma unroll
        for (int b = 0; b < 2; ++b)
#pragma unroll
            for (int m = 0; m < 4; ++m)
#pragma unroll
                for (int n = 0; n < 2; ++n) acc[a][b][m][n] = (f32x4){0.f, 0.f, 0.f, 0.f};
    bf16x8 At[4][2], B0[2][2], B1[2][2];
    const char* cA = (const char*)g.A + (size_t)cur.pm * tstep + (size_t)cur.ko * 2; const char* cB = (const char*)g.Bt + (size_t)cur.pn * tstep + (size_t)cur.ko * 2;
    S.a_ready(cur);
    if constexpr (SP2) {
        PG8_STAGE(PG8_SB(0, 0), cB, voffB); PG8_STAGE(PG8_SB(0, 1), cB + hstep, voffB); PG8_STAGE(PG8_SA(0, 0), cA, voffA); PG8_STAGE(PG8_SA(0, 1), cA + hstep, voffA);
        if (wr == 1) PG8_BAR;
        PG8_WAIT_V(2); PG8_BAR;
        PG8_STAGE(PG8_SB(1, 0), cB + kstep, voffB); PG8_STAGE(PG8_SA(1, 0), cA + kstep, voffA); PG8_STAGE(PG8_SB(1, 1), cB + hstep + kstep, voffB);
        PG8_WAIT_V(6); PG8_BAR;
    } else {
        PG8_STAGE(PG8_SB(0, 0), cB, voffB); PG8_STAGE(PG8_SA(0, 0), cA, voffA); PG8_STAGE(PG8_SB(0, 1), cB + hstep, voffB); PG8_STAGE(PG8_SA(0, 1), cA + hstep, voffA);
        if (wr == 1) PG8_BAR;
        PG8_WAIT_V(4); PG8_BAR;
        PG8_STAGE(PG8_SB(1, 0), cB + kstep, voffB); PG8_STAGE(PG8_SA(1, 0), cA + kstep, voffA); PG8_STAGE(PG8_SB(1, 1), cB + hstep + kstep, voffB);
        PG8_WAIT_V(6); PG8_BAR;
    }
    for (;;) {
        const bool has_next = S.next(ui + 1, nxt);
        const char* nA = has_next ? (const char*)g.A + (size_t)nxt.pm * tstep + (size_t)nxt.ko * 2 : cA; const char* nB = has_next ? (const char*)g.Bt + (size_t)nxt.pn * tstep + (size_t)nxt.ko * 2 : cB;
        for (int t = 0; t < nt; t += 2) {
            const bool last = (t == nt - 2);
            const char* a1 = cA + (size_t)(t + 1) * kstep;
            const char* a2 = last ? nA : cA + (size_t)(t + 2) * kstep; const char* b2 = last ? nB : cB + (size_t)(t + 2) * kstep;
            const char* a3 = a2 + kstep; const char* b3 = b2 + kstep;
            if (last && has_next) S.a_ready(nxt);
            if constexpr (SP2) {
            PG8_LDB(B0, 0, 0); PG8_LDB(B1, 0, 1); PG8_SCHED; PG8_LDA(At, 0, 0); PG8_STAGE(PG8_SA(1, 1), a1 + hstep, voffA);
            PG8_WAIT_V(8); PG8_WAIT_L(0); PG8_BAR; PG8_MMA(0, 0, At, B0); PG8_MMA(0, 1, At, B1); PG8_BAR; PG8_SCHED;
            PG8_LDA(At, 0, 1); PG8_STAGE(PG8_SB(0, 0), b2, voffB); PG8_STAGE(PG8_SB(0, 1), b2 + hstep, voffB); PG8_STAGE(PG8_SA(0, 0), a2, voffA);
            PG8_WAIT_V(8); PG8_WAIT_L(0); PG8_BAR; if constexpr (!HALFM) { PG8_MMA(1, 0, At, B0); PG8_MMA(1, 1, At, B1); } PG8_BAR; PG8_SCHED;
            PG8_LDB(B0, 1, 0); PG8_LDB(B1, 1, 1); PG8_SCHED; PG8_LDA(At, 1, 0); PG8_STAGE(PG8_SA(0, 1), a2 + hstep, voffA);
            PG8_WAIT_V(8); PG8_WAIT_L(0); PG8_BAR; PG8_MMA(0, 0, At, B0); PG8_MMA(0, 1, At, B1); PG8_BAR; PG8_SCHED;
            PG8_LDA(At, 1, 1); PG8_STAGE(PG8_SB(1, 0), b3, voffB); PG8_STAGE(PG8_SB(1, 1), b3 + hstep, voffB); PG8_STAGE(PG8_SA(1, 0), a3, voffA);
            PG8_WAIT_V(8); PG8_WAIT_L(0); PG8_BAR; if constexpr (!HALFM) { PG8_MMA(1, 0, At, B0); PG8_MMA(1, 1, At, B1); } PG8_BAR; PG8_SCHED;
            } else {
            PG8_LDB(B0, 0, 0); PG8_SCHED; PG8_LDA(At, 0, 0); PG8_STAGE(PG8_SA(1, 1), a1 + hstep, voffA);
            PG8_WAIT_L(8); PG8_BAR; PG8_WAIT_L(0); PG8_MMA(0, 0, At, B0); PG8_BAR; PG8_SCHED;
            PG8_LDB(B1, 0, 1); PG8_STAGE(PG8_SB(0, 0), b2, voffB);
            PG8_BAR; PG8_WAIT_L(0); PG8_MMA(0, 1, At, B1); PG8_BAR;
            PG8_LDA(At, 0, 1); PG8_STAGE(PG8_SA(0, 0), a2, voffA);
            PG8_BAR; PG8_WAIT_L(0); PG8_MMA(1, 0, At, B0); PG8_BAR; PG8_SCHED;
            PG8_STAGE(PG8_SB(0, 1), b2 + hstep, voffB);
            PG8_WAIT_V(6); PG8_BAR; PG8_MMA(1, 1, At, B1); PG8_BAR;
            PG8_LDB(B0, 1, 0); PG8_SCHED; PG8_LDA(At, 1, 0); PG8_STAGE(PG8_SA(0, 1), a2 + hstep, voffA);
            PG8_WAIT_L(8); PG8_BAR; PG8_WAIT_L(0); PG8_MMA(0, 0, At, B0); PG8_BAR; PG8_SCHED;
            PG8_LDB(B1, 1, 1); PG8_STAGE(PG8_SB(1, 0), b3, voffB);
            PG8_BAR; PG8_WAIT_L(0); PG8_MMA(0, 1, At, B1); PG8_BAR;
            PG8_LDA(At, 1, 1); PG8_STAGE(PG8_SA(1, 0), a3, voffA);
            PG8_BAR; PG8_WAIT_L(0); PG8_MMA(1, 0, At, B0); PG8_BAR; PG8_SCHED;
            PG8_STAGE(PG8_SB(1, 1), b3 + hstep, voffB);
            PG8_WAIT_V(6); PG8_BAR; PG8_MMA(1, 1, At, B1); PG8_BAR;
            }
        }
        if constexpr (ALIGN_EPI) { if (wr == 0) PG8_BAR; }
        if constexpr (!Epi::AFTER_DRAIN) { E(acc, cur, wr, wc, fr, fq); S.done(cur); }
        if (!has_next) break;
#pragma unroll
        for (int a = 0; a < 2; ++a)
#pragma unroll
            for (int b = 0; b < 2; ++b)
#pragma unroll
                for (int m = 0; m < 4; ++m)
#pragma unroll
                    for (int n = 0; n < 2; ++n) acc[a][b][m][n] = (f32x4){0.f, 0.f, 0.f, 0.f};
        cur = nxt; cA = nA; cB = nB; ++ui;
        if constexpr (ALIGN_EPI) { if (wr == 1) PG8_BAR; }
    }
    PG8_WAIT_V(0);
    if constexpr (!ALIGN_EPI) { if (wr == 0) PG8_BAR; }
    PG8_BAR;
    if constexpr (Epi::AFTER_DRAIN) { E.fused(acc, cur, wr, wc, fr, fq, lds, wid, lane); S.done(cur); }
#undef PG8_SA
#undef PG8_SB
#undef PG8_STAGE
#undef PG8_LDA
#undef PG8_LDB
#undef PG8_MMA
#undef PG8_WAIT_V
#undef PG8_WAIT_L
#undef PG8_BAR
#undef PG8_SCHED
}
}


constexpr int RING_OFF = 0, RING_BYTES = 139264;
constexpr int LDSCTL_OFF = RING_BYTES, MISC_OFF = LDSCTL_OFF + 320;
constexpr int LDS_BYTES = 147456;
static_assert(MISC_OFF + 128 <= LDS_BYTES, "LDS map");

#define GAS __attribute__((address_space(1)))
#define LAS __attribute__((address_space(3)))
typedef unsigned short bf16;
typedef unsigned v4u __attribute__((ext_vector_type(4)));
typedef unsigned v2u __attribute__((ext_vector_type(2)));
typedef float f32x4 __attribute__((ext_vector_type(4)));
typedef float f32x16 __attribute__((ext_vector_type(16)));
typedef short bf16x8 __attribute__((ext_vector_type(8)));
typedef short s16x4 __attribute__((ext_vector_type(4)));
typedef GAS unsigned gu32;
#define RLX_AGENT __ATOMIC_RELAXED, __HIP_MEMORY_SCOPE_AGENT
#define LDS_WAIT() asm volatile("s_waitcnt lgkmcnt(0)" ::: "memory")
#define VM_WAIT() asm volatile("s_waitcnt vmcnt(0)" ::: "memory")
__device__ __forceinline__ unsigned f2bf(float f) { unsigned u = __builtin_bit_cast(unsigned, f); return (u + 0x7fffu + ((u >> 16) & 1u)) >> 16; }
__device__ __forceinline__ unsigned pk2(float lo, float hi) { return f2bf(lo) | (f2bf(hi) << 16); }
__device__ __forceinline__ float bflo(unsigned w) { return __builtin_bit_cast(float, w << 16); }
__device__ __forceinline__ float bfhi(unsigned w) { return __builtin_bit_cast(float, w & 0xffff0000u); }
using pg8::ex2; using pg8::sigm; using pg8::silu_f;
__device__ __forceinline__ int fresh_lane() { int l = threadIdx.x & 63; asm volatile("" : "+v"(l)); return l; }
__device__ __forceinline__ int fresh_tid() { int t = threadIdx.x; asm volatile("" : "+v"(t)); return t; }
#define XB_TMO      128
#define XB_XCNT(j)  (256  + 64 * (j))
#define XB_XSUB(j)  (1280 + 64 * (j))
#define XB_XGEN(j)  (2304 + 64 * (j))
#define XB_TOP      3328
#define XB_TOPGEN   3392
#define XCD_BAR_WORDS 3456
#define XB_SPIN_CAP (1u << 18)

__device__ __forceinline__ unsigned xb_ld(unsigned* p)              { return __hip_atomic_load(p, __ATOMIC_RELAXED, __HIP_MEMORY_SCOPE_AGENT); }
__device__ __forceinline__ unsigned xb_add(unsigned* p, unsigned v) { return __hip_atomic_fetch_add(p, v, __ATOMIC_RELAXED, __HIP_MEMORY_SCOPE_AGENT); }
__device__ __forceinline__ unsigned xb_xcc_id() { return (unsigned)__builtin_amdgcn_s_getreg((3 << 11) | 20) & 0xFu; }
#define XB_SPIN(cond, bar) do { unsigned _sp = 0; while (cond) { __builtin_amdgcn_s_sleep(1); \
    if ((++_sp & 255u) == 0u) { if (xb_ld(&(bar)[XB_TMO])) break; if (_sp > XB_SPIN_CAP) { atomicAdd(&(bar)[XB_TMO], 1u); break; } } } } while (0)

struct XcdBarrier {
    unsigned* bar; unsigned x;
    volatile LAS unsigned* st;
};

__device__ __forceinline__ XcdBarrier xcd_barrier_post(unsigned* bar, volatile LAS unsigned* st) {
    XcdBarrier b; b.bar = bar; b.x = xb_xcc_id(); b.st = st;
    if (threadIdx.x == 0) (void)xb_add(&bar[XB_XCNT(b.x)], 1u);
    return b;
}
__device__ __forceinline__ void xcd_barrier_complete(unsigned* bar, unsigned x, unsigned& nloc, unsigned& nx) {
    const unsigned G = gridDim.x * gridDim.y * gridDim.z;
    unsigned sum, cnt, mine, sp = 0u;
    for (;;) {
        sum = 0u; cnt = 0u; mine = 0u;
#pragma unroll
        for (unsigned j = 0; j < 16; ++j) { const unsigned c = xb_ld(&bar[XB_XCNT(j)]); sum += c; cnt += (c > 0u) ? 1u : 0u; mine = (j == x) ? c : mine; }
        if (sum == G) break;
        __builtin_amdgcn_s_sleep(1);
        if ((++sp & 255u) == 0u) { if (xb_ld(&bar[XB_TMO])) break; if (sp > XB_SPIN_CAP) { atomicAdd(&bar[XB_TMO], 1u); break; } }
    }
    nloc = mine > 0u ? mine : 1u; nx = cnt > 0u ? cnt : 1u;
}

__device__ __forceinline__ void xcd_barrier(const XcdBarrier& b) {
    asm volatile("s_waitcnt vmcnt(0)" ::: "memory");
    __syncthreads();
    if (threadIdx.x == 0) {
        unsigned* bar = b.bar;
        __builtin_amdgcn_s_waitcnt(0);
        unsigned nloc = b.st[0], nx = b.st[1];
        if (nloc == 0u) { xcd_barrier_complete(bar, b.x, nloc, nx); b.st[0] = nloc; b.st[1] = nx; }
        const unsigned old = xb_add(&bar[XB_XSUB(b.x)], 1u);
        const unsigned gen = old / nloc;
        if (old + 1u == (gen + 1u) * nloc) {
            __builtin_amdgcn_fence(__ATOMIC_RELEASE, "agent");
            asm volatile("s_waitcnt vmcnt(0)" ::: "memory");
            const unsigned og = xb_add(&bar[XB_TOP], 1u);
            const unsigned tg = og / nx;
            if (og + 1u == (tg + 1u) * nx) xb_add(&bar[XB_TOPGEN], 1u);
            else XB_SPIN(xb_ld(&bar[XB_TOPGEN]) == tg, bar);
            __builtin_amdgcn_fence(__ATOMIC_ACQUIRE, "agent");
            xb_add(&bar[XB_XGEN(b.x)], 1u);
            asm volatile("s_waitcnt vmcnt(0)" ::: "memory");
        } else {
            XB_SPIN(xb_ld(&bar[XB_XGEN(b.x)]) == gen, bar);
            __builtin_amdgcn_fence(__ATOMIC_ACQUIRE, "agent");
            asm volatile("s_waitcnt vmcnt(0)" ::: "memory");
        }
    }
    __syncthreads();
}

struct Args { const float* in[32]; float* out; unsigned char* ws; };
struct Frame {
    LAS unsigned char* lds;
    volatile LAS unsigned* MISC;
    gu32* ctl;
    int tid, lane, wave, G;
};
__device__ const float INV_FREQ[32] = {1.000000000e+00f, 7.498942614e-01f, 5.623413324e-01f, 4.216965139e-01f, 3.162277639e-01f, 2.371373773e-01f, 1.778279394e-01f, 1.333521307e-01f,
    1.000000015e-01f, 7.498941571e-02f, 5.623413250e-02f, 4.216965288e-02f, 3.162277490e-02f, 2.371373773e-02f, 1.778279431e-02f, 1.333521493e-02f,
    9.999999776e-03f, 7.498941850e-03f, 5.623413250e-03f, 4.216964822e-03f, 3.162277630e-03f, 2.371373586e-03f, 1.778279431e-03f, 1.333521446e-03f,
    1.000000047e-03f, 7.498942432e-04f, 5.623413017e-04f, 4.216965172e-04f, 3.162277571e-04f, 2.371373703e-04f, 1.778279402e-04f, 1.333521504e-04f};

__device__ __forceinline__ float wave_sum(float v) {
#pragma unroll
    for (int o = 1; o < 64; o <<= 1) v += __shfl_xor(v, o);
    return v;
}
__device__ __forceinline__ void sincos_d(double a, double& s, double& c) {
    const double k = __builtin_rint(a * 0.15915494309189535);
    double r = __builtin_fma(-k, 6.283185307179586, a);
    r = __builtin_fma(-k, 2.4492935982947064e-16, r);
    const double r2 = r * r;
    double sa = 1.0, ca = 1.0;
#pragma unroll
    for (int n = 15; n >= 1; --n) { sa = 1.0 - sa * r2 * (1.0 / (double)((2 * n) * (2 * n + 1))); ca = 1.0 - ca * r2 * (1.0 / (double)((2 * n - 1) * (2 * n))); }
    s = sa * r; c = ca;
}

__device__ __forceinline__ void p0_load(const float* colp, int ldw, const float* gain, int k0, int lane, float (&w)[32]) {
#pragma unroll
    for (int i = 0; i < 32; ++i) { const int kk = 2 * i + (lane >> 5); float x = colp ? colp[(size_t)(k0 + kk) * ldw] : 0.f; if (gain) x *= gain[k0 + kk]; w[i] = x; }
}
__device__ __forceinline__ void p0_store(const float (&w)[32], int K, bf16* WT, int v0, int k0, LAS float* scr, int lane) {
#pragma unroll
    for (int i = 0; i < 32; ++i) { const int kk = 2 * i + (lane >> 5); scr[kk * 33 + (lane & 31)] = w[i]; }
    LDS_WAIT(); asm volatile("" ::: "memory");
    const int c = lane & 7;
#pragma unroll
    for (int j = 0; j < 4; ++j) { const int n = (lane >> 3) + 8 * j; const LAS float* s = scr + (8 * c) * 33 + n;
        v4u o; o.x = pk2(s[0 * 33], s[1 * 33]); o.y = pk2(s[2 * 33], s[3 * 33]); o.z = pk2(s[4 * 33], s[5 * 33]); o.w = pk2(s[6 * 33], s[7 * 33]);
        *(GAS v4u*)(WT + (size_t)(v0 + n) * K + k0 + 8 * c) = o; }
    LDS_WAIT(); asm volatile("" ::: "memory");
}
__device__ __forceinline__ int win_src(int v) {
    if (v < 5120) return v;
    if (v < 8192) { const int isk = v >= 6656, w = v - (isk ? 6656 : 5120), head = w >> 6, j = w & 63, dim = (j & 1) ? 32 + (j >> 1) : (j >> 1); return (isk ? 6688 : 5152) + head * 64 + dim; }
    if (v < 9728) return 8224 + (v - 8192);
    if (v < 10752) return 9760 + (v - 9728);
    if (v < 11776) return 10784 + (v - 10752);
    if (v < 11808) return 5120 + (v - 11776);
    return -1;
}
__device__ __forceinline__ void norm_row_bf16(const float* xrow, const float* gain, bf16* orow, int lane) {
    const GAS f32x4* xr = (const GAS f32x4*)xrow + lane; const GAS f32x4* gr = (const GAS f32x4*)gain + lane;
    f32x4 v[4]; float s = 0.f;
#pragma unroll
    for (int j = 0; j < 4; ++j) { v[j] = xr[64 * j]; s += (v[j].x * v[j].x + v[j].y * v[j].y) + (v[j].z * v[j].z + v[j].w * v[j].w); }
    const float rstd = 1.0f / sqrtf(wave_sum(s) * (1.f / 1024.f) + EPS);
    GAS unsigned long long* o8 = (GAS unsigned long long*)orow + lane;
#pragma unroll
    for (int j = 0; j < 4; ++j) { const f32x4 g = gr[64 * j];
        o8[64 * j] = (unsigned long long)pk2(v[j].x * rstd * g.x, v[j].y * rstd * g.y) | ((unsigned long long)pk2(v[j].z * rstd * g.z, v[j].w * rstd * g.w) << 32); }
}
__device__ __forceinline__ void norm_row_f32(const float* xrow, const float* gain, float* orow, int lane) {
    const GAS f32x4* xr = (const GAS f32x4*)xrow + lane; const GAS f32x4* gr = (const GAS f32x4*)gain + lane;
    f32x4 v[4]; float s = 0.f;
#pragma unroll
    for (int j = 0; j < 4; ++j) { v[j] = xr[64 * j]; s += (v[j].x * v[j].x + v[j].y * v[j].y) + (v[j].z * v[j].z + v[j].w * v[j].w); }
    const float rstd = 1.0f / sqrtf(wave_sum(s) * (1.f / 1024.f) + EPS);
    GAS f32x4* o = (GAS f32x4*)orow + lane;
#pragma unroll
    for (int j = 0; j < 4; ++j) { const f32x4 g = gr[64 * j]; o[64 * j] = v[j] * rstd * g; }
}
template <bool OUTF32> __device__ __forceinline__ void norm_rows4(const float* x, const float* gain, void* out, size_t m, size_t step, int lane) {
    f32x4 v[4][4]; float s[4];
#pragma unroll
    for (int r = 0; r < 4; ++r) { const GAS f32x4* xr = (const GAS f32x4*)(x + (m + r * step) * 1024) + lane;
#pragma unroll
        for (int j = 0; j < 4; ++j) v[r][j] = xr[64 * j]; }
    f32x4 g[4];
#pragma unroll
    for (int j = 0; j < 4; ++j) g[j] = ((const GAS f32x4*)gain)[lane + 64 * j];
#pragma unroll
    for (int r = 0; r < 4; ++r) { float q = 0.f;
#pragma unroll
        for (int j = 0; j < 4; ++j) q += (v[r][j].x * v[r][j].x + v[r][j].y * v[r][j].y) + (v[r][j].z * v[r][j].z + v[r][j].w * v[r][j].w);
        s[r] = q; }
#pragma unroll
    for (int o = 1; o < 64; o <<= 1) {
#pragma unroll
        for (int r = 0; r < 4; ++r) s[r] += __shfl_xor(s[r], o); }
#pragma unroll
    for (int r = 0; r < 4; ++r) { const float rstd = 1.0f / sqrtf(s[r] * (1.f / 1024.f) + EPS);
        if (OUTF32) { GAS f32x4* o = (GAS f32x4*)((float*)out + (m + r * step) * 1024) + lane;
#pragma unroll
            for (int j = 0; j < 4; ++j) o[64 * j] = v[r][j] * rstd * g[j]; }
        else { GAS unsigned long long* o8 = (GAS unsigned long long*)((bf16*)out + (m + r * step) * 1024) + lane;
#pragma unroll
            for (int j = 0; j < 4; ++j) o8[64 * j] = (unsigned long long)pk2(v[r][j].x * rstd * g[j].x, v[r][j].y * rstd * g[j].y) | ((unsigned long long)pk2(v[r][j].z * rstd * g[j].z, v[r][j].w * rstd * g[j].w) << 32); }
    }
}
__device__ __forceinline__ void final_rows4(const bf16* h, const float* gain, float* out, size_t m, size_t step, int nrows, int lane) {
    v4u v[4][2]; float s[4];
#pragma unroll
    for (int r = 0; r < 4; ++r) { const size_t mm = m + (r < nrows ? r : 0) * step; v[r][0] = ((const GAS v4u*)(h + mm * 1024))[lane]; v[r][1] = ((const GAS v4u*)(h + mm * 1024))[lane + 64]; }
    f32x4 g[4];
#pragma unroll
    for (int j = 0; j < 2; ++j) { g[2 * j] = ((const GAS f32x4*)gain)[128 * j + 2 * lane]; g[2 * j + 1] = ((const GAS f32x4*)gain)[128 * j + 2 * lane + 1]; }
    float x[4][16];
#pragma unroll
    for (int r = 0; r < 4; ++r) { float q = 0.f;
#pragma unroll
        for (int j = 0; j < 2; ++j) { const v4u w = v[r][j];
            x[r][8 * j + 0] = bflo(w.x); x[r][8 * j + 1] = bfhi(w.x); x[r][8 * j + 2] = bflo(w.y); x[r][8 * j + 3] = bfhi(w.y); x[r][8 * j + 4] = bflo(w.z); x[r][8 * j + 5] = bfhi(w.z); x[r][8 * j + 6] = bflo(w.w); x[r][8 * j + 7] = bfhi(w.w); }
#pragma unroll
        for (int e = 0; e < 16; ++e) q += x[r][e] * x[r][e];
        s[r] = q; }
#pragma unroll
    for (int o = 1; o < 64; o <<= 1) {
#pragma unroll
        for (int r = 0; r < 4; ++r) s[r] += __shfl_xor(s[r], o); }
#pragma unroll
    for (int r = 0; r < 4; ++r) if (r < nrows) { const float rstd = 1.0f / sqrtf(s[r] * (1.f / 1024.f) + EPS);
        GAS f32x4* o = (GAS f32x4*)(out + (m + r * step) * 1024);
#pragma unroll
        for (int j = 0; j < 2; ++j) { o[128 * j + 2 * lane] = (f32x4){x[r][8 * j] * rstd * g[2 * j][0], x[r][8 * j + 1] * rstd * g[2 * j][1], x[r][8 * j + 2] * rstd * g[2 * j][2], x[r][8 * j + 3] * rstd * g[2 * j][3]};
            o[128 * j + 2 * lane + 1] = (f32x4){x[r][8 * j + 4] * rstd * g[2 * j + 1][0], x[r][8 * j + 5] * rstd * g[2 * j + 1][1], x[r][8 * j + 6] * rstd * g[2 * j + 1][2], x[r][8 * j + 7] * rstd * g[2 * j + 1][3]}; }
    }
}
__device__ __forceinline__ void norm_phase(const Frame& F, const float* HR, const float* gain, bf16* U) {
    const int gw = blockIdx.x * NWAVES + F.wave, NGW = F.G * NWAVES;
    for (int m = gw; m < M_REAL; m += NGW) norm_row_bf16(HR + (size_t)m * 1024, gain, U + (size_t)m * 1024, fresh_lane());
}

__device__ __forceinline__ void p0_prologue(const Frame& F, const Args& A) {
    unsigned char* ws = A.ws;
    LAS float* scr = (LAS float*)(F.lds + RING_OFF + F.wave * 16384);
    const int gw = blockIdx.x * NWAVES + F.wave, NGW = F.G * NWAVES, lane = fresh_lane();
    constexpr int NK[10] = {16, 44, 16, 32, 8, 16, 16, 44, 16, 4};
    constexpr int NN[10] = {176, 32, 376, 32, 32, 32, 176, 32, 32, 32};
    int total = 0;
#pragma unroll
    for (int k = 0; k < 10; ++k) total += NK[k] * NN[k];
    auto decode = [&](int it, const float*& colp, int& ldw, const float*& gain, int& K, bf16*& WT, int& v0, int& k0) {
        int r = it, kind = 0;
#pragma unroll
        for (int k = 0; k < 9; ++k) { if (kind == k && r >= NK[k] * NN[k]) { r -= NK[k] * NN[k]; kind = k + 1; } }
        int nn = 32; const float* src = nullptr; K = 1024; ldw = 1024; gain = nullptr; WT = nullptr;
        switch (kind) {
            case 0: nn = 176; K = 1024; ldw = 2816; WT = (bf16*)(ws + WS_W1A); break;
            case 1: nn = 32; K = 2816; ldw = 1024; src = A.in[12]; WT = (bf16*)(ws + WS_W2A); break;
            case 2: nn = 376; K = 1024; ldw = 11808; src = A.in[14]; gain = A.in[13]; WT = (bf16*)(ws + WS_WIN); break;
            case 3: nn = 32; K = 2048; ldw = 1024; src = A.in[21]; gain = A.in[20]; WT = (bf16*)(ws + WS_WOS); break;
            case 4: nn = 32; K = 512; ldw = 1024; src = A.in[22]; WT = (bf16*)(ws + WS_WOA); break;
            case 5: nn = 32; K = 1024; ldw = 1024; src = A.in[23]; WT = (bf16*)(ws + WS_WOUT); break;
            case 6: nn = 176; K = 1024; ldw = 2816; gain = A.in[24]; WT = (bf16*)(ws + WS_W1B); break;
            case 7: nn = 32; K = 2816; ldw = 1024; src = A.in[27]; WT = (bf16*)(ws + WS_W2B); break;
            case 8: nn = 32; K = 1024; ldw = 1024; src = A.in[29]; gain = A.in[28]; WT = (bf16*)(ws + WS_WPG); break;
            default: nn = 32; K = 256; ldw = 1024; src = A.in[30]; WT = (bf16*)(ws + WS_WPP); break;
        }
        const int kb = r / nn, nb = r % nn, v = nb * 32 + (lane & 31);
        if (kind == 0 || kind == 6) { const int tile = v >> 8, w = v & 255; colp = (w < 128 ? A.in[kind == 0 ? 10 : 25] : A.in[kind == 0 ? 11 : 26]) + tile * 128 + (w & 127); }
        else if (kind == 2) { const int sc = win_src(v); colp = sc >= 0 ? src + sc : nullptr; }
        else colp = src + v;
        v0 = nb * 32; k0 = kb * 64;
    };
    {
        float wc[32]; int Kc = 0, v0c = 0, k0c = 0; bf16* WTc = nullptr;
        if (gw < total) { const float* colp; const float* gain; int ldw; decode(gw, colp, ldw, gain, Kc, WTc, v0c, k0c); p0_load(colp, ldw, gain, k0c, lane, wc); }
        for (int it = gw; it < total; it += NGW) {
            float wn[32]; int Kn = 0, v0n = 0, k0n = 0; bf16* WTn = nullptr;
            const bool more = it + NGW < total;
            if (more) { const float* colp; const float* gain; int ldw; decode(it + NGW, colp, ldw, gain, Kn, WTn, v0n, k0n); p0_load(colp, ldw, gain, k0n, lane, wn); }
            p0_store(wc, Kc, WTc, v0c, k0c, scr, lane);
            if (more) {
#pragma unroll
                for (int i = 0; i < 32; ++i) wc[i] = wn[i];
                Kc = Kn; v0c = v0n; k0c = k0n; WTc = WTn; }
        }
    }
    {
        float* cs = (float*)(ws + WS_CS);
        const int gt = blockIdx.x * (NWAVES * 64) + fresh_tid(), NT = F.G * NWAVES * 64;
        for (int e = gt; e < 8193 * 32; e += NT) { const int pos = e >> 5, i = e & 31; const float ang = (float)pos * INV_FREQ[i];
            double s, c; sincos_d((double)ang, s, c); cs[(size_t)pos * 64 + (i >> 1) * 4 + (i & 1) * 2 + 0] = (float)c; cs[(size_t)pos * 64 + (i >> 1) * 4 + (i & 1) * 2 + 1] = (float)s; }
    }
    {
        bf16* U = (bf16*)(ws + WS_U); bf16* PB = (bf16*)(ws + WS_PB); bf16* YG = (bf16*)(ws + WS_YG); bf16* AO = (bf16*)(ws + WS_AO);
        for (int m = gw; m + 3 * NGW < P_ROWS; m += 4 * NGW) {
            f32x4 p[4];
#pragma unroll
            for (int r = 0; r < 4; ++r) p[r] = ((const GAS f32x4*)(A.in[7] + ((size_t)m + (size_t)r * NGW) * 256))[lane];
            norm_rows4<false>(A.in[0], A.in[9], U, (size_t)m, (size_t)NGW, lane);
#pragma unroll
            for (int r = 0; r < 4; ++r) { const size_t mm = (size_t)m + (size_t)r * NGW;
                ((GAS v2u*)(PB + mm * 256))[lane] = (v2u){pk2(p[r].x, p[r].y), pk2(p[r].z, p[r].w)};
                if (lane < 3) ((float*)(ws + WS_SQ2))[(size_t)lane * M_PAD + mm] = 0.f; }
        }
        const int mrest = (P_ROWS / (4 * NGW)) * (4 * NGW);
        for (int m = mrest + gw; m < M_PAD; m += NGW) {
            if (m < M_REAL) {
                const float* xr = m < P_ROWS ? A.in[0] + (size_t)m * 1024 : A.in[1] + (size_t)(m - P_ROWS) * 1024;
                norm_row_bf16(xr, A.in[9], U + (size_t)m * 1024, lane);
                const float* pr = m < P_ROWS ? A.in[7] + (size_t)m * 256 : A.in[8] + (size_t)(m - P_ROWS) * 256;
                const f32x4 p = ((const GAS f32x4*)pr)[lane];
                ((GAS v2u*)(PB + (size_t)m * 256))[lane] = (v2u){pk2(p.x, p.y), pk2(p.z, p.w)};
            } else {
                const v4u z = (v4u){0u, 0u, 0u, 0u};
                ((GAS v4u*)(U + (size_t)m * 1024))[lane] = z; ((GAS v4u*)(U + (size_t)m * 1024))[lane + 64] = z;
                if (lane < 32) ((GAS v4u*)(PB + (size_t)m * 256))[lane] = z;
#pragma unroll
                for (int j = 0; j < 4; ++j) ((GAS v4u*)(YG + (size_t)m * 2048))[lane + 64 * j] = z;
                ((GAS v4u*)(AO + (size_t)m * 512))[lane] = z;
                if (lane == 0) ((float*)(ws + WS_RSTD))[m] = 0.f;
            }
            if (lane < 3) ((float*)(ws + WS_SQ2))[(size_t)lane * M_PAD + m] = 0.f;
            if (m >= P_ROWS) {
                GAS f32x4* hr = (GAS f32x4*)((float*)(ws + WS_HR) + (size_t)m * 1024) + lane; GAS f32x4* t1 = (GAS f32x4*)((float*)(ws + WS_T1S) + (size_t)(m - P_ROWS) * 1024) + lane;
#pragma unroll
                for (int j = 0; j < 4; ++j) { hr[64 * j] = m < M_REAL ? ((const GAS f32x4*)(A.in[1] + (size_t)(m - P_ROWS) * 1024))[lane + 64 * j] : (f32x4){0.f, 0.f, 0.f, 0.f}; t1[64 * j] = (f32x4){0.f, 0.f, 0.f, 0.f}; }
            }
        }
    }
}
__device__ __forceinline__ void sample_norm_phase(const Frame& F, const float* HR, bf16* HB, float* ssq) {
    const int gw = blockIdx.x * NWAVES + F.wave, NGW = F.G * NWAVES, lane = fresh_lane();
    for (int m = P_ROWS + gw; m < M_REAL; m += NGW) {
        const GAS f32x4* xr = (const GAS f32x4*)(HR + (size_t)m * 1024) + lane; float s = 0.f;
        GAS unsigned long long* o8 = (GAS unsigned long long*)(HB + (size_t)m * 1024) + lane;
#pragma unroll
        for (int j = 0; j < 4; ++j) { const f32x4 v = xr[64 * j]; s += (v.x * v.x + v.y * v.y) + (v.z * v.z + v.w * v.w);
            o8[64 * j] = (unsigned long long)pk2(v.x, v.y) | ((unsigned long long)pk2(v.z, v.w) << 32); }
        s = wave_sum(s);
        if (lane == 0) ssq[m] = s;
    }
}

typedef short v4i16_t __attribute__((ext_vector_type(4)));
constexpr float LOG2E = 1.4426950408889634f;
constexpr size_t O_KVS0 = pg8::EpiWin::O_KVS0, O_KVS1 = pg8::EpiWin::O_KVS1, O_KVS2 = pg8::EpiWin::O_KVS2, O_CONVS = pg8::EpiWin::O_CONVS, O_SSMS = pg8::EpiWin::O_SSMS, O_SSMP = pg8::EpiWin::O_SSMP;
__device__ __forceinline__ s16x4 trr(LAS unsigned char* p) { return __builtin_bit_cast(s16x4, __builtin_amdgcn_ds_read_tr16_b64_v4i16((LAS v4i16_t*)p)); }
__device__ __forceinline__ bf16x8 cat8(s16x4 lo, s16x4 hi) { return (bf16x8){lo[0], lo[1], lo[2], lo[3], hi[0], hi[1], hi[2], hi[3]}; }
__device__ __forceinline__ bf16x8 packf8(float a0, float a1, float a2, float a3, float a4, float a5, float a6, float a7) {
    v4u w; w.x = pg8::cvt_pk_bf16(a0, a1); w.y = pg8::cvt_pk_bf16(a2, a3); w.z = pg8::cvt_pk_bf16(a4, a5); w.w = pg8::cvt_pk_bf16(a6, a7); return __builtin_bit_cast(bf16x8, w); }
#define MFMA32(a, b, c) __builtin_amdgcn_mfma_f32_32x32x16_bf16((a), (b), (c), 0, 0, 0)

__device__ __forceinline__ void conv_prepass(const Frame& F, const Args& A) {
    unsigned char* ws = A.ws;
    const int gt = blockIdx.x * (NWAVES * 64) + fresh_tid(), NT = F.G * NWAVES * 64, nper = NT / 128, nthr = nper * 128;
    if (gt >= nthr) return;
    const int cc = 256 + gt % 128, c0 = 8 * cc;
    float cw0[8], cw1[8], cw2[8], cw3[8], cbs[8];
#pragma unroll
    for (int e = 0; e < 8; ++e) { cw0[e] = A.in[15][c0 + e]; cw1[e] = A.in[15][3072 + c0 + e]; cw2[e] = A.in[15][2 * 3072 + c0 + e]; cw3[e] = A.in[15][3 * 3072 + c0 + e]; cbs[e] = A.in[16][c0 + e]; }
    const bf16* XB = (const bf16*)(ws + WS_XBC) + c0; bf16* XC = (bf16*)(ws + WS_XC) + c0;
    for (int seg = gt / 128; seg < P_ROWS / 16; seg += nper) {
        const int row0 = seg * 16, tb = row0 & (SEQ_T - 1);
        float r0[8], r1[8], r2[8], cur[8];
#pragma unroll
        for (int i = 0; i < 19; ++i) {
            const v4u rw = (tb - 3 + i >= 0) ? *(const GAS v4u*)(XB + (size_t)(row0 - 3 + i) * 3072) : (v4u){0u, 0u, 0u, 0u};
            cur[0] = bflo(rw.x); cur[1] = bfhi(rw.x); cur[2] = bflo(rw.y); cur[3] = bfhi(rw.y); cur[4] = bflo(rw.z); cur[5] = bfhi(rw.z); cur[6] = bflo(rw.w); cur[7] = bfhi(rw.w);
            if (i >= 3) {
                float y[8];
#pragma unroll
                for (int e = 0; e < 8; ++e) { const float v = cbs[e] + cw0[e] * r0[e] + cw1[e] * r1[e] + cw2[e] * r2[e] + cw3[e] * cur[e]; y[e] = silu_f(v); }
                *(GAS bf16x8*)(XC + (size_t)(row0 + i - 3) * 3072) = packf8(y[0], y[1], y[2], y[3], y[4], y[5], y[6], y[7]);
            }
#pragma unroll
            for (int e = 0; e < 8; ++e) { r0[e] = r1[e]; r1[e] = r2[e]; r2[e] = cur[e]; }
        }
    }
}

constexpr int XS_ = 144, BS_ = 272;
constexpr int L_XT = 0, L_XST = L_XT + 128 * XS_, L_BT = L_XST + 128 * XS_, L_CT = L_BT + 128 * BS_, L_ST = L_CT + 128 * BS_, L_ARR = L_ST + 64 * BS_, L_CWL = L_ARR + 3072, L_HALO = L_CWL + 1280, L_SSD_END = L_HALO + 8 * 2 * 3 * XS_;
static_assert(L_SSD_END <= RING_BYTES, "SSD LDS map");

__device__ __forceinline__ void ssd_stream(const Frame& F, const Args& A, int sidx) {
    unsigned char* ws = A.ws;
    const int lane = fresh_lane(), w = F.wave, tid = fresh_tid(), r32 = lane & 31, hh = lane >> 5;
    const int qq = (lane & 15) >> 2, pp = lane & 3, cb16 = (lane >> 4) & 1;
    const int pairi = (sidx & 7) * 4 + (sidx >> 6), b = pairi >> 2, g = pairi & 3, hd = g * 8 + ((sidx >> 3) & 7);
    LAS unsigned char* XT = F.lds + L_XT; LAS unsigned char* XST = F.lds + L_XST; LAS unsigned char* BT = F.lds + L_BT; LAS unsigned char* CT = F.lds + L_CT; LAS unsigned char* ST = F.lds + L_ST;
    const float a2 = -ex2(A.in[18][hd] * LOG2E) * LOG2E;
    const float Dsk = A.in[19][hd];
    const int pt = w >> 2, lt = w < 4 ? w : 7 - w, nt = w & 3;
    f32x16 st;
#pragma unroll
    for (int i = 0; i < 16; ++i) st[i] = 0.f;
    const GAS unsigned char* XCg = (const GAS unsigned char*)(ws + WS_XC) + (size_t)b * SEQ_T * 3072 * 2;
    const GAS unsigned char* XBg = (const GAS unsigned char*)(ws + WS_XBC) + (size_t)b * SEQ_T * 3072 * 2;
    const GAS unsigned char* DTg = (const GAS unsigned char*)(ws + WS_DT) + ((size_t)b * SEQ_T * 32 + hd) * 4;
    const GAS unsigned char* Zg = (const GAS unsigned char*)(ws + WS_Z) + (size_t)b * SEQ_T * 2048 * 2;
    GAS unsigned char* YGg = (GAS unsigned char*)(ws + WS_YG) + (size_t)b * SEQ_T * 2048 * 2;
    GAS unsigned char* SSQg = (GAS unsigned char*)(ws + WS_SSQ) + (size_t)b * SEQ_T * 64 * 4;
    const unsigned xoff = (unsigned)((tid >> 3) * 3072 + hd * 64 + 8 * (tid & 7)) * 2u;
    const unsigned boff = (unsigned)((tid >> 4) * 3072 + 2048 + g * 128 + 8 * (tid & 15)) * 2u;
    const int xdst = (tid >> 3) * XS_ + 16 * (tid & 7), bdst = (tid >> 4) * BS_ + 16 * (tid & 15);
    const unsigned doff = (unsigned)(2 * lane) * 128u;
    const int hrow = 8 * w - 3 + (lane >> 3);
    const unsigned hoff = (unsigned)(hd * 64 + 8 * (lane & 7)) * 2u;
    LAS unsigned char* HAL = F.lds + L_HALO + w * (2 * 3 * XS_);
    LAS float* CWL = (LAS float*)(F.lds + L_CWL);
    if (tid < 320) CWL[tid] = tid < 256 ? A.in[15][(tid >> 6) * 3072 + hd * 64 + (tid & 63)] : A.in[16][hd * 64 + (tid & 63)];
    const int lcol = 32 * lt + r32;
    const unsigned zoff = (unsigned)(lcol * 2048 + hd * 64 + 32 * pt + 4 * hh) * 2u;
    const unsigned soff = (unsigned)(lcol * 64 + hd * 2 + pt) * 4u;
    v4u pfx[2], pfh[2], pfb[4], pfc[4]; float pd0 = 0.f, pd1 = 0.f;
#pragma unroll
    for (int i = 0; i < 2; ++i) { pfx[i] = *(const GAS v4u*)(XBg + (size_t)i * (64 * 6144) + xoff);
        pfh[i] = (lane < 24 && hrow + 64 * i >= 0) ? *(const GAS v4u*)(XBg + (ptrdiff_t)(hrow + 64 * i) * 6144 + hoff) : (v4u){0u, 0u, 0u, 0u}; }
#pragma unroll
    for (int i = 0; i < 4; ++i) { pfb[i] = *(const GAS v4u*)(XCg + (size_t)i * (32 * 6144) + boff); pfc[i] = *(const GAS v4u*)(XCg + (size_t)i * (32 * 6144) + 1024 + boff); }
    if (w == 0) { pd0 = *(const GAS float*)(DTg + doff); pd1 = *(const GAS float*)(DTg + 128 + doff); }

#define SSD_SCAN(ARRP) do { if (w == 0) { LAS float* arr_ = (ARRP); const float a0 = pd0 * a2, a1 = pd1 * a2; float x = a0 + a1; \
            _Pragma("unroll") for (int o = 1; o < 64; o <<= 1) { const float v = __shfl_up(x, o); if (lane >= o) x += v; } \
            arr_[2 * lane] = x - a1; arr_[2 * lane + 1] = x; arr_[128 + 2 * lane] = pd0; arr_[128 + 2 * lane + 1] = pd1; \
            const float E_ = __shfl(x, lane | 15); arr_[256 + 2 * lane] = ex2(E_ - (x - a1)) * pd0; arr_[256 + 2 * lane + 1] = ex2(E_ - x) * pd1; } } while (0)
    SSD_SCAN((LAS float*)(F.lds + L_ARR));
    for (int ck = 0; ck < 64; ++ck) {
        const int t0 = ck * 128;
        LAS float* arr = (LAS float*)(F.lds + L_ARR + (ck & 1) * 1536);
        __syncthreads();
#pragma unroll
        for (int q4 = 0; q4 < 4; ++q4) { v2u o; o.x = pg8::cvt_pk_bf16(st[4 * q4], st[4 * q4 + 1]); o.y = pg8::cvt_pk_bf16(st[4 * q4 + 2], st[4 * q4 + 3]);
            *(LAS v2u*)(ST + (32 * pt + r32) * BS_ + (32 * nt + 8 * q4 + 4 * hh) * 2) = o; }
        {
            const float aL = arr[127];
#pragma unroll
            for (int i = 0; i < 2; ++i) { *(LAS v4u*)(XST + xdst + 64 * i * XS_) = pfx[i]; if (lane < 24) *(LAS v4u*)(HAL + (3 * i + (lane >> 3)) * XS_ + 16 * (lane & 7)) = pfh[i]; }
            v4u rw[2][4];
#pragma unroll
            for (int i = 0; i < 2; ++i)
#pragma unroll
                for (int k = 0; k < 4; ++k) { const int lr = (lane >> 3) + k - 3;
                    LAS unsigned char* src = lr >= 0 ? XST + (8 * w + lr + 64 * i) * XS_ + 16 * (lane & 7) : HAL + (3 * i + 3 + lr) * XS_ + 16 * (lane & 7);
                    rw[i][k] = *(LAS v4u*)src; }
            f32x4 cwa[5], cwb[5];
#pragma unroll
            for (int k = 0; k < 5; ++k) { cwa[k] = *(LAS f32x4*)(CWL + 64 * k + 8 * (lane & 7)); cwb[k] = *(LAS f32x4*)(CWL + 64 * k + 8 * (lane & 7) + 4); }
            asm volatile("s_waitcnt lgkmcnt(0)" ::: "memory");
#pragma unroll
            for (int i = 0; i < 2; ++i) {
                const int row = (tid >> 3) + 64 * i;
                float y[8];
#pragma unroll
                for (int e = 0; e < 8; ++e) y[e] = e < 4 ? cwa[4][e] : cwb[4][e - 4];
#pragma unroll
                for (int k = 0; k < 4; ++k) { const v4u r = rw[i][k];
                    y[0] += cwa[k][0] * bflo(r.x); y[1] += cwa[k][1] * bfhi(r.x); y[2] += cwa[k][2] * bflo(r.y); y[3] += cwa[k][3] * bfhi(r.y);
                    y[4] += cwb[k][0] * bflo(r.z); y[5] += cwb[k][1] * bfhi(r.z); y[6] += cwb[k][2] * bflo(r.w); y[7] += cwb[k][3] * bfhi(r.w); }
#pragma unroll
                for (int e = 0; e < 8; ++e) y[e] = silu_f(y[e]);
                *(LAS bf16x8*)(XT + xdst + 64 * i * XS_) = packf8(y[0], y[1], y[2], y[3], y[4], y[5], y[6], y[7]);
                const float te = ex2(aL - arr[row]) * arr[128 + row];
                *(LAS bf16x8*)(XST + xdst + 64 * i * XS_) = packf8(y[0] * te, y[1] * te, y[2] * te, y[3] * te, y[4] * te, y[5] * te, y[6] * te, y[7] * te);
            }
#pragma unroll
            for (int i = 0; i < 4; ++i) { *(LAS v4u*)(BT + bdst + 32 * i * BS_) = pfb[i]; *(LAS v4u*)(CT + bdst + 32 * i * BS_) = pfc[i]; }
        }
        v2u zw[4];
        { const GAS unsigned char* zb = Zg + (size_t)t0 * 4096;
#pragma unroll
          for (int q4 = 0; q4 < 4; ++q4) zw[q4] = *(const GAS v2u*)(zb + 16 * q4 + zoff); }
        if (ck < 63) {
            const GAS unsigned char* xb = XCg + (size_t)(t0 + 128) * 6144; const GAS unsigned char* rb = XBg + (size_t)(t0 + 128) * 6144;
#pragma unroll
            for (int i = 0; i < 2; ++i) { pfx[i] = *(const GAS v4u*)(rb + (size_t)i * (64 * 6144) + xoff);
                if (lane < 24) pfh[i] = *(const GAS v4u*)(rb + (ptrdiff_t)(hrow + 64 * i) * 6144 + hoff); }
#pragma unroll
            for (int i = 0; i < 4; ++i) { pfb[i] = *(const GAS v4u*)(xb + (size_t)i * (32 * 6144) + boff); pfc[i] = *(const GAS v4u*)(xb + (size_t)i * (32 * 6144) + 1024 + boff); }
            if (w == 0) { const GAS unsigned char* db = DTg + (size_t)(t0 + 128) * 128; pd0 = *(const GAS float*)(db + doff); pd1 = *(const GAS float*)(db + 128 + doff); }
        }
        __syncthreads();
        const float acs_l = arr[lcol];
        int r32o = r32; asm volatile("" : "+v"(r32o));
        bf16x8 cf[8], af[8];
#pragma unroll
        for (int s = 0; s < 8; ++s) { cf[s] = *(LAS bf16x8*)(CT + lcol * BS_ + (16 * s + 8 * hh) * 2); af[s] = *(LAS bf16x8*)(ST + (32 * pt + r32) * BS_ + (16 * s + 8 * hh) * 2); }
        __builtin_amdgcn_sched_barrier(0);
        f32x16 Y;
#pragma unroll
        for (int i = 0; i < 16; ++i) Y[i] = 0.f;
#pragma unroll
        for (int s = 0; s < 8; ++s) Y = MFMA32(af[s], cf[s], Y);
        { const float el = ex2(acs_l);
#pragma unroll
          for (int i = 0; i < 16; ++i) Y[i] *= el; }
#pragma unroll 1
        for (int sti = 0; sti <= lt; ++sti) {
            {
                bf16x8 bfA[8]; f32x4 as4[4], dt4[4]; s16x4 xlo[2], xhi[2];
#pragma unroll
                for (int s = 0; s < 8; ++s) bfA[s] = *(LAS bf16x8*)(BT + (32 * sti + r32) * BS_ + (16 * s + 8 * hh) * 2);
                __builtin_amdgcn_sched_barrier(0);
                f32x16 Gt;
#pragma unroll
                for (int i = 0; i < 16; ++i) Gt[i] = 0.f;
#pragma unroll
                for (int s = 0; s < 8; ++s) Gt = MFMA32(bfA[s], cf[s], Gt);
#pragma unroll
                for (int s2 = 0; s2 < 2; ++s2) { LAS unsigned char* xa = XT + (32 * sti + 16 * s2 + 4 * hh + qq) * XS_ + (32 * pt + 16 * cb16 + 4 * pp) * 2; xlo[s2] = trr(xa); xhi[s2] = trr(xa + 8 * XS_); }
                if (sti < lt) {
                    const float fl = ex2(acs_l - arr[32 * sti + 31]);
#pragma unroll
                    for (int q4 = 0; q4 < 4; ++q4) { as4[q4] = *(LAS f32x4*)(arr + 256 + 32 * sti + 8 * q4 + 4 * hh);
#pragma unroll
                        for (int e = 0; e < 4; ++e) Gt[4 * q4 + e] = Gt[4 * q4 + e] * as4[q4][e] * fl; }
                } else {
#pragma unroll
                    for (int q4 = 0; q4 < 4; ++q4) { const int s0 = 32 * sti + 8 * q4 + 4 * hh; as4[q4] = *(LAS f32x4*)(arr + s0); dt4[q4] = *(LAS f32x4*)(arr + 128 + s0); }
#pragma unroll
                    for (int q4 = 0; q4 < 4; ++q4) {
#pragma unroll
                        for (int e = 0; e < 4; ++e) { float wv = Gt[4 * q4 + e] * ex2(fminf(acs_l - as4[q4][e], 0.f)) * dt4[q4][e]; if ((8 * q4 + 4 * hh + e) > r32o) wv = 0.f; Gt[4 * q4 + e] = wv; }
                    }
                }
#pragma unroll
                for (int s2 = 0; s2 < 2; ++s2) {
                    const bf16x8 wf = packf8(Gt[8 * s2], Gt[8 * s2 + 1], Gt[8 * s2 + 2], Gt[8 * s2 + 3], Gt[8 * s2 + 4], Gt[8 * s2 + 5], Gt[8 * s2 + 6], Gt[8 * s2 + 7]);
                    Y = MFMA32(cat8(xlo[s2], xhi[s2]), wf, Y);
                }
                __builtin_amdgcn_sched_barrier(0);
            }
        }
        {
            GAS unsigned char* yb = YGg + (size_t)t0 * 4096;
            float ssq = 0.f;
#pragma unroll
            for (int q4 = 0; q4 < 4; ++q4) {
                const int p0 = 32 * pt + 8 * q4 + 4 * hh;
                const v2u xw = *(LAS v2u*)(XT + lcol * XS_ + p0 * 2);
                const float y0 = (Y[4 * q4 + 0] + Dsk * bflo(xw.x)) * silu_f(bflo(zw[q4].x)), y1 = (Y[4 * q4 + 1] + Dsk * bfhi(xw.x)) * silu_f(bfhi(zw[q4].x));
                const float y2 = (Y[4 * q4 + 2] + Dsk * bflo(xw.y)) * silu_f(bflo(zw[q4].y)), y3 = (Y[4 * q4 + 3] + Dsk * bfhi(xw.y)) * silu_f(bfhi(zw[q4].y));
                ssq += (y0 * y0 + y1 * y1) + (y2 * y2 + y3 * y3);
                v2u o; o.x = pg8::cvt_pk_bf16(y0, y1); o.y = pg8::cvt_pk_bf16(y2, y3);
                *(GAS v2u*)(yb + 16 * q4 + zoff) = o;
            }
            ssq += __shfl_xor(ssq, 32);
            if (hh == 0) *(GAS float*)(SSQg + (size_t)t0 * 256 + soff) = ssq;
        }
        {
            const float eL = ex2(arr[127]);
#pragma unroll
            for (int i = 0; i < 16; ++i) st[i] *= eL;
#pragma unroll
            for (int kg = 0; kg < 2; ++kg) {
                s16x4 alo[4], ahi[4], blo[4], bhi[4];
#pragma unroll
                for (int k4 = 0; k4 < 4; ++k4) { const int ks = 4 * kg + k4;
                    LAS unsigned char* ba = BT + (16 * ks + 8 * hh + qq) * BS_ + (32 * nt + 16 * cb16 + 4 * pp) * 2;
                    LAS unsigned char* xa = XST + (16 * ks + 8 * hh + qq) * XS_ + (32 * pt + 16 * cb16 + 4 * pp) * 2;
                    alo[k4] = trr(ba); ahi[k4] = trr(ba + 4 * BS_); blo[k4] = trr(xa); bhi[k4] = trr(xa + 4 * XS_); }
                __builtin_amdgcn_sched_barrier(0);
#pragma unroll
                for (int k4 = 0; k4 < 4; ++k4) st = MFMA32(cat8(alo[k4], ahi[k4]), cat8(blo[k4], bhi[k4]), st);
            }
        }
        if (ck < 63) SSD_SCAN((LAS float*)(F.lds + L_ARR + ((ck + 1) & 1) * 1536));
    }
#undef SSD_SCAN
    {
        float* so = A.out + O_SSMP + ((size_t)(b * 32 + hd) * 64 + 32 * pt + r32) * 128 + 32 * nt + 4 * hh;
#pragma unroll
        for (int q4 = 0; q4 < 4; ++q4) *(GAS f32x4*)(so + 8 * q4) = (f32x4){st[4 * q4], st[4 * q4 + 1], st[4 * q4 + 2], st[4 * q4 + 3]};
    }
    __syncthreads();
}

constexpr int KS_ = 144, L_AK = 0, L_AV = 384 * KS_;
static_assert(2 * 384 * KS_ <= RING_BYTES, "attention LDS map");
struct AttnU { size_t tokbase; int dil, k0, colq, g, h; };
__device__ __forceinline__ AttnU attn_unit_decode(int u) {
    AttnU r; const int g = u >> 11, r1 = u & 2047, b = r1 >> 8, r2 = r1 & 255, h = r2 >> 5, blk = r2 & 31;
    const int dsh = 2 * g, res = blk >> (5 - dsh), qb = blk & ((32 >> dsh) - 1);
    r.dil = 1 << dsh; r.tokbase = (size_t)b * SEQ_T + res; r.k0 = 256 * qb - 128; r.colq = (g * 8 + h) * 64; r.g = g; r.h = h; return r;
}
__device__ __forceinline__ void attn_prefetch(const AttnU& U, bool cont, const bf16* Kb, const bf16* Vb, const bf16* Qb, int tid, int wave, int lane, v4u (&pk)[6], v4u (&pv)[6], bf16x8 (&qn)[4]) {
    const int r0 = cont ? 128 : 0, nch = cont ? 4 : 6;
#pragma unroll
    for (int i = 0; i < 6; ++i) { const int ci = tid + 512 * i, row = r0 + (ci >> 3), c8 = ci & 7, key = U.k0 + row;
        if (i >= nch) { pk[i] = (v4u){0u, 0u, 0u, 0u}; pv[i] = pk[i]; }
        else if (key >= 0) { const size_t o = (U.tokbase + (size_t)U.dil * key) * AW + U.colq + 8 * c8; pk[i] = *(const GAS v4u*)(Kb + o); pv[i] = *(const GAS v4u*)(Vb + o); }
        else { pk[i] = (v4u){0u, 0u, 0u, 0u}; pv[i] = pk[i]; } }
    const bf16* qrow = Qb + (U.tokbase + (size_t)U.dil * (U.k0 + 128 + 32 * wave + (lane & 31))) * AW + U.colq + 8 * (lane >> 5);
#pragma unroll
    for (int s = 0; s < 4; ++s) qn[s] = *(const GAS bf16x8*)(qrow + 16 * s);
}
__device__ __forceinline__ void attn_prompt_phase(const Frame& F, const Args& A) {
    unsigned char* ws = A.ws;
    const int lane = fresh_lane(), w = F.wave, tid = fresh_tid(), r32 = lane & 31, hh = lane >> 5;
    const int qq = (lane & 15) >> 2, pp = lane & 3, cb16 = (lane >> 4) & 1;
    const bf16* Qb = (const bf16*)(ws + WS_Q); const bf16* Kb = (const bf16*)(ws + WS_K); const bf16* Vb = (const bf16*)(ws + WS_V);
    constexpr int NU = 3 * 8 * 8 * 32;
    const int per = (NU + F.G - 1) / F.G, lo = blockIdx.x * per, hi = (lo + per < NU) ? lo + per : NU;
    if (lo >= hi) return;
    LAS unsigned char* AK = F.lds + L_AK; LAS unsigned char* AV = F.lds + L_AV;
    v4u pk[6], pv[6]; bf16x8 qn[4];
    AttnU U = attn_unit_decode(lo);
    attn_prefetch(U, false, Kb, Vb, Qb, tid, w, lane, pk, pv, qn);
    int rot = 0; bool cont = false;
    for (int u = lo; u < hi; ++u) {
        __syncthreads();
        rot = cont ? (rot + 8 >= 12 ? rot - 4 : rot + 8) : 0;
        { const int r0 = cont ? 128 : 0, nch = cont ? 4 : 6;
#pragma unroll
          for (int i = 0; i < 6; ++i) if (i < nch) { const int ci = tid + 512 * i, rl = r0 + (ci >> 3), c8 = ci & 7; int sl = rot + (rl >> 5); sl = sl >= 12 ? sl - 12 : sl;
              const int row = sl * 32 + (rl & 31); *(LAS v4u*)(AK + row * KS_ + 16 * c8) = pk[i]; *(LAS v4u*)(AV + row * KS_ + 16 * c8) = pv[i]; } }
        bf16x8 qf[4];
#pragma unroll
        for (int s = 0; s < 4; ++s) qf[s] = qn[s];
        const AttnU C = U;
        if (u + 1 < hi) { U = attn_unit_decode(u + 1);
            cont = (((u + 1) >> 5) == (u >> 5)) && (U.tokbase == C.tokbase) && (U.k0 == C.k0 + 256);
            attn_prefetch(U, cont, Kb, Vb, Qb, tid, w, lane, pk, pv, qn); }
        __syncthreads();
        int r32o = r32; asm volatile("" : "+v"(r32o));
        const int tfirst = (C.k0 < 0) ? 4 - w : 0;
        float m = -INFINITY;
#pragma unroll
        for (int kt = 0; kt < 5; ++kt) {
            if (kt >= tfirst) {
                f32x16 S;
#pragma unroll
                for (int i = 0; i < 16; ++i) S[i] = 0.f;
                int sl = rot + w + kt; sl = sl >= 12 ? sl - 12 : sl;
                LAS unsigned char* kp = AK + (32 * sl + r32) * KS_ + 16 * hh;
                bf16x8 kf[4];
#pragma unroll
                for (int s = 0; s < 4; ++s) kf[s] = *(LAS bf16x8*)(kp + 32 * s);
                __builtin_amdgcn_sched_barrier(0);
#pragma unroll
                for (int s = 0; s < 4; ++s) S = MFMA32(kf[s], qf[s], S);
#pragma unroll
                for (int rr = 0; rr < 16; ++rr) { const int keyrow = (rr & 3) + 8 * (rr >> 2) + 4 * hh; float v = S[rr]; if (kt == 0 && keyrow < r32o) v = -INFINITY; if (kt == 4 && keyrow > r32o) v = -INFINITY; m = fmaxf(m, v); }
            }
        }
        m = fmaxf(m, __shfl_xor(m, 32));
        float lsum = 0.f;
        f32x16 O0, O1;
#pragma unroll
        for (int i = 0; i < 16; ++i) { O0[i] = 0.f; O1[i] = 0.f; }
#pragma unroll
        for (int kt = 0; kt < 5; ++kt) {
            if (kt >= tfirst) {
                f32x16 S;
#pragma unroll
                for (int i = 0; i < 16; ++i) S[i] = 0.f;
                int sl = rot + w + kt; sl = sl >= 12 ? sl - 12 : sl;
                LAS unsigned char* kp = AK + (32 * sl + r32) * KS_ + 16 * hh;
                bf16x8 kf[4]; s16x4 vlo0[2], vhi0[2], vlo1[2], vhi1[2];
#pragma unroll
                for (int s = 0; s < 4; ++s) kf[s] = *(LAS bf16x8*)(kp + 32 * s);
#pragma unroll
                for (int s2 = 0; s2 < 2; ++s2) { LAS unsigned char* va = AV + (32 * sl + 16 * s2 + 4 * hh + qq) * KS_ + (16 * cb16 + 4 * pp) * 2;
                    vlo0[s2] = trr(va); vhi0[s2] = trr(va + 8 * KS_); vlo1[s2] = trr(va + 64); vhi1[s2] = trr(va + 8 * KS_ + 64); }
                __builtin_amdgcn_sched_barrier(0);
#pragma unroll
                for (int s = 0; s < 4; ++s) S = MFMA32(kf[s], qf[s], S);
#pragma unroll
                for (int rr = 0; rr < 16; ++rr) { const int keyrow = (rr & 3) + 8 * (rr >> 2) + 4 * hh; float p = ex2(S[rr] - m); if (kt == 0 && keyrow < r32o) p = 0.f; if (kt == 4 && keyrow > r32o) p = 0.f; S[rr] = p; lsum += p; }
#pragma unroll
                for (int s2 = 0; s2 < 2; ++s2) {
                    const bf16x8 pf = packf8(S[8 * s2], S[8 * s2 + 1], S[8 * s2 + 2], S[8 * s2 + 3], S[8 * s2 + 4], S[8 * s2 + 5], S[8 * s2 + 6], S[8 * s2 + 7]);
                    O0 = MFMA32(cat8(vlo0[s2], vhi0[s2]), pf, O0);
                    O1 = MFMA32(cat8(vlo1[s2], vhi1[s2]), pf, O1);
                }
            }
        }
        lsum += __shfl_xor(lsum, 32);
        const float inv = 1.0f / lsum;
        const size_t orow = C.tokbase + (size_t)C.dil * (C.k0 + 128 + 32 * w + r32);
        bf16* op = (bf16*)(ws + WS_AOG) + (size_t)C.g * AOG_STRIDE + orow * 512 + C.h * 64 + 4 * hh;
#pragma unroll
        for (int q4 = 0; q4 < 4; ++q4) {
            v2u o; o.x = pg8::cvt_pk_bf16(O0[4 * q4] * inv, O0[4 * q4 + 1] * inv); o.y = pg8::cvt_pk_bf16(O0[4 * q4 + 2] * inv, O0[4 * q4 + 3] * inv);
            *(GAS v2u*)(op + 8 * q4) = o;
            v2u o2; o2.x = pg8::cvt_pk_bf16(O1[4 * q4] * inv, O1[4 * q4 + 1] * inv); o2.y = pg8::cvt_pk_bf16(O1[4 * q4 + 2] * inv, O1[4 * q4 + 3] * inv);
            *(GAS v2u*)(op + 32 + 8 * q4) = o2;
        }
        if (hh == 0) ((float*)(ws + WS_LSE))[(size_t)C.g * LSE_STRIDE + orow * 8 + C.h] = m + __builtin_amdgcn_logf(lsum);
    }
    __syncthreads();
}

__device__ __forceinline__ void attn_sample_item(const Frame& F, const Args& A, int it) {
    unsigned char* ws = A.ws;
    const int lane = fresh_lane(), kq = lane >> 2, part = lane & 3;
    const int b = it / 24, hq = it % 24, g = hq >> 3, h = hq & 7;
    const int W = 128 << (2 * g), dil = 1 << (2 * g);
    const float* cache = A.in[2 + g];
    const size_t row = (size_t)P_ROWS + b;
    const bf16* qrow = (const bf16*)(ws + WS_Q) + row * AW + hq * 64 + 32 * (part & 1);
    const bf16* krow = (const bf16*)(ws + WS_K) + row * AW + hq * 64 + 32 * (part & 1);
    const bf16* vrow = (const bf16*)(ws + WS_V) + row * AW + hq * 64;
    float qn[16]; float snew = 0.f;
#pragma unroll
    for (int c = 0; c < 4; ++c) {
        const v4u qw = *(const GAS v4u*)(qrow + 8 * c), kw = *(const GAS v4u*)(krow + 8 * c);
        const bool od = part >= 2;
        qn[4 * c + 0] = od ? bfhi(qw.x) : bflo(qw.x); qn[4 * c + 1] = od ? bfhi(qw.y) : bflo(qw.y); qn[4 * c + 2] = od ? bfhi(qw.z) : bflo(qw.z); qn[4 * c + 3] = od ? bfhi(qw.w) : bflo(qw.w);
        snew += qn[4 * c + 0] * (od ? bfhi(kw.x) : bflo(kw.x)) + qn[4 * c + 1] * (od ? bfhi(kw.y) : bflo(kw.y)) + qn[4 * c + 2] * (od ? bfhi(kw.z) : bflo(kw.z)) + qn[4 * c + 3] * (od ? bfhi(kw.w) : bflo(kw.w));
    }
    snew += __shfl_xor(snew, 1); snew += __shfl_xor(snew, 2);
    const float* kbase = cache + ((size_t)b * W * 2 + 0) * 512 + h * 64 + 16 * part;
    float sc[8];
#pragma unroll
    for (int jj = 0; jj < 8; ++jj) {
        const float* kr = kbase + (size_t)(W - dil * (kq + 16 * jj + 1)) * 1024;
        float acc = 0.f;
#pragma unroll
        for (int i = 0; i < 4; ++i) { const f32x4 kv = *(const GAS f32x4*)(kr + 4 * i); acc += (qn[4 * i] * kv[0] + qn[4 * i + 1] * kv[1]) + (qn[4 * i + 2] * kv[2] + qn[4 * i + 3] * kv[3]); }
        sc[jj] = acc;
    }
#pragma unroll
    for (int jj = 0; jj < 8; ++jj) { sc[jj] += __shfl_xor(sc[jj], 1); sc[jj] += __shfl_xor(sc[jj], 2); }
    float m = snew;
#pragma unroll
    for (int jj = 0; jj < 8; ++jj) m = fmaxf(m, sc[jj]);
#pragma unroll
    for (int o = 4; o < 64; o <<= 1) m = fmaxf(m, __shfl_xor(m, o));
    float lpart = 0.f;
#pragma unroll
    for (int jj = 0; jj < 8; ++jj) { sc[jj] = ex2(sc[jj] - m); lpart += sc[jj]; }
    const float pn = ex2(snew - m);
    const float lsum = wave_sum(lpart) * 0.25f + pn;
    const float* vbase = cache + ((size_t)b * W * 2 + 1) * 512 + h * 64 + lane;
    float o = pn * bflo((unsigned)vrow[lane]);
#pragma unroll
    for (int j2 = 0; j2 < 4; ++j2) {
        float vv[32];
#pragma unroll
        for (int kk = 0; kk < 32; ++kk) vv[kk] = vbase[(size_t)(W - dil * (kk + 32 * j2 + 1)) * 1024];
#pragma unroll
        for (int kk = 0; kk < 32; ++kk) o += __shfl(sc[2 * j2 + (kk >> 4)], 4 * (kk & 15)) * vv[kk];
    }
    o *= 1.0f / lsum;
    ((bf16*)(ws + WS_AOG))[(size_t)g * AOG_STRIDE + row * 512 + h * 64 + lane] = (bf16)f2bf(o);
    if (lane == 0) ((float*)(ws + WS_LSE))[(size_t)g * LSE_STRIDE + row * 8 + h] = m + __builtin_amdgcn_logf(lsum);
}

__device__ __forceinline__ float conv1(const float* sc, const bf16* nw, const float* cwp, const float* cbp, int c) {
    return silu_f(cbp[c] + cwp[c] * sc[c] + cwp[3072 + c] * sc[3072 + c] + cwp[2 * 3072 + c] * sc[2 * 3072 + c] + cwp[3 * 3072 + c] * bflo((unsigned)nw[c]));
}
__device__ __forceinline__ void ssd_sample_item(const Frame& F, const Args& A, int it) {
    unsigned char* ws = A.ws;
    const int lane = fresh_lane(), r32 = lane & 31, hh = lane >> 5;
    const int b = it >> 5, hd = it & 31, g = hd >> 3;
    const float* sc = A.in[5] + (size_t)b * 3 * 3072;
    const bf16* nw = (const bf16*)(ws + WS_XBC) + ((size_t)P_ROWS + b) * 3072;
    const float* cwp = A.in[15]; const float* cbp = A.in[16];
    const float xv = conv1(sc, nw, cwp, cbp, hd * 64 + lane);
    float Bv[4], Cv[4];
#pragma unroll
    for (int e = 0; e < 4; ++e) { Bv[e] = conv1(sc, nw, cwp, cbp, 2048 + g * 128 + 4 * r32 + e); Cv[e] = conv1(sc, nw, cwp, cbp, 2560 + g * 128 + 4 * r32 + e); }
    const size_t row = (size_t)P_ROWS + b;
    const float dt = ((const float*)(ws + WS_DT))[row * 32 + hd];
    const float dA = ex2(dt * (-ex2(A.in[18][hd] * LOG2E)) * LOG2E);
    const float Dsk = A.in[19][hd];
    const float* sin_ = A.in[6] + ((size_t)(b * 32 + hd) * 64) * 128 + 4 * r32;
    float* sout = A.out + O_SSMS + ((size_t)(b * 32 + hd) * 64) * 128 + 4 * r32;
    float yp[32];
#pragma unroll
    for (int i8 = 0; i8 < 2; ++i8) {
        f32x4 sv[16];
#pragma unroll
        for (int k = 0; k < 16; ++k) sv[k] = *(const GAS f32x4*)(sin_ + (size_t)(2 * (16 * i8 + k) + hh) * 128);
#pragma unroll
        for (int k = 0; k < 16; ++k) { const int i = 16 * i8 + k, p = 2 * i + hh;
            const float dx = dt * __shfl(xv, p);
            f32x4 sn; sn[0] = dA * sv[k][0] + dx * Bv[0]; sn[1] = dA * sv[k][1] + dx * Bv[1]; sn[2] = dA * sv[k][2] + dx * Bv[2]; sn[3] = dA * sv[k][3] + dx * Bv[3];
            *(GAS f32x4*)(sout + (size_t)p * 128) = sn;
            yp[i] = (Cv[0] * sn[0] + Cv[1] * sn[1]) + (Cv[2] * sn[2] + Cv[3] * sn[3]); }
    }
#pragma unroll
    for (int d = 16; d >= 1; d >>= 1) {
        const bool up = (r32 & d) != 0;
#pragma unroll
        for (int i = 0; i < d; ++i) { const float give = up ? yp[i] : yp[i + d], keep = up ? yp[i + d] : yp[i]; yp[i] = keep + __shfl_xor(give, d); }
    }
    const float ykeep = yp[0];
    const int pl = 2 * r32 + hh;
    const float xl = __shfl(xv, pl);
    const float z = bflo((unsigned)((const bf16*)(ws + WS_Z))[row * 2048 + hd * 64 + pl]);
    const float yg = (ykeep + Dsk * xl) * silu_f(z);
    ((bf16*)(ws + WS_YG))[row * 2048 + hd * 64 + pl] = (bf16)f2bf(yg);
    const float ssq = wave_sum(yg * yg);
    if (lane == 0) { float* q = (float*)(ws + WS_SSQ) + row * 64 + hd * 2; q[0] = ssq; q[1] = 0.f; }
}

__device__ __forceinline__ void emit_kv_rows4(const bf16* const (&kp)[4], const bf16* const (&vp)[4], float* const (&dp)[4], int lane) {
    const int hl = lane >> 3, c = lane & 7;
    v4u a[4], b[4], w[4];
#pragma unroll
    for (int r = 0; r < 4; ++r) { a[r] = *(const GAS v4u*)(kp[r] + hl * 64 + 16 * (c & 3)); b[r] = *(const GAS v4u*)(kp[r] + hl * 64 + 16 * (c & 3) + 8); w[r] = *(const GAS v4u*)(vp[r] + 8 * lane); }
#pragma unroll
    for (int r = 0; r < 4; ++r) { f32x4 o0, o1;
        if (c < 4) { o0 = (f32x4){bflo(a[r].x), bflo(a[r].y), bflo(a[r].z), bflo(a[r].w)}; o1 = (f32x4){bflo(b[r].x), bflo(b[r].y), bflo(b[r].z), bflo(b[r].w)}; }
        else       { o0 = (f32x4){bfhi(a[r].x), bfhi(a[r].y), bfhi(a[r].z), bfhi(a[r].w)}; o1 = (f32x4){bfhi(b[r].x), bfhi(b[r].y), bfhi(b[r].z), bfhi(b[r].w)}; }
        float* d = dp[r] + hl * 64 + 8 * c; *(GAS f32x4*)d = o0; *(GAS f32x4*)(d + 4) = o1;
        float* q = dp[r] + 512 + 8 * lane; *(GAS f32x4*)q = (f32x4){bflo(w[r].x), bfhi(w[r].x), bflo(w[r].y), bfhi(w[r].y)}; *(GAS f32x4*)(q + 4) = (f32x4){bflo(w[r].z), bfhi(w[r].z), bflo(w[r].w), bfhi(w[r].w)}; }
}
__device__ __forceinline__ void emit_outputs(const Frame& F, const Args& A) {
    unsigned char* ws = A.ws;
    const int gw = blockIdx.x * NWAVES + F.wave, NGW = F.G * NWAVES, lane = fresh_lane();
    const bf16* Kb = (const bf16*)(ws + WS_K); const bf16* Vb = (const bf16*)(ws + WS_V);
    constexpr int NR = 8 * 2688 + 3 * 128;
    for (int r = gw; r < NR; r += 4 * NGW) {
        const bf16* kp[4]; const bf16* vp[4]; float* dp[4];
#pragma unroll
        for (int k = 0; k < 4; ++k) {
            int rr = r + k * NGW; if (rr >= NR) rr = r;
            if (rr < 8 * 2688) { const int b = rr / 2688, q = rr % 2688;
                const int g = q < 128 ? 0 : (q < 640 ? 1 : 2), tw = q - (g == 0 ? 0 : (g == 1 ? 128 : 640)), W = 128 << (2 * g);
                const size_t row = (size_t)b * SEQ_T + (SEQ_T - W) + tw;
                kp[k] = Kb + row * AW + g * 512; vp[k] = Vb + row * AW + g * 512;
                dp[k] = A.out + (g == 0 ? pg8::EpiWin::O_KVP0 : (g == 1 ? pg8::EpiWin::O_KVP1 : pg8::EpiWin::O_KVP2)) + ((size_t)b * W + tw) * 1024;
            } else { const int q = rr - 8 * 2688, g = q >> 7, b = q & 127; const size_t row = (size_t)P_ROWS + b;
                kp[k] = Kb + row * AW + g * 512; vp[k] = Vb + row * AW + g * 512;
                dp[k] = A.out + (g == 0 ? O_KVS0 : (g == 1 ? O_KVS1 : O_KVS2)) + (size_t)b * 1024; }
        }
        emit_kv_rows4(kp, vp, dp, lane);
    }
    const bf16* XB = (const bf16*)(ws + WS_XBC);
    const int gt = blockIdx.x * (NWAVES * 64) + fresh_tid(), NT = F.G * NWAVES * 64;
    for (int e = gt; e < 8 * 3 * 384; e += NT) { const int rr = e / 384, c8 = e % 384, b = rr / 3, k = rr % 3;
        const v4u a = *(const GAS v4u*)(XB + ((size_t)b * SEQ_T + SEQ_T - 3 + k) * 3072 + 8 * c8);
        float* d = A.out + pg8::EpiWin::O_CONVP + (size_t)rr * 3072 + 8 * c8; *(GAS f32x4*)d = (f32x4){bflo(a.x), bfhi(a.x), bflo(a.y), bfhi(a.y)}; *(GAS f32x4*)(d + 4) = (f32x4){bflo(a.z), bfhi(a.z), bflo(a.w), bfhi(a.w)}; }
    for (int e = gt; e < 128 * 384; e += NT) { const int b = e / 384, c8 = e % 384;
        const v4u a = *(const GAS v4u*)(XB + ((size_t)P_ROWS + b) * 3072 + 8 * c8);
        float* d = A.out + O_CONVS + ((size_t)b * 3 + 2) * 3072 + 8 * c8; *(GAS f32x4*)d = (f32x4){bflo(a.x), bfhi(a.x), bflo(a.y), bfhi(a.y)}; *(GAS f32x4*)(d + 4) = (f32x4){bflo(a.z), bfhi(a.z), bflo(a.w), bfhi(a.w)}; }
    for (int e = gt; e < 128 * 2 * 768; e += NT) { const int bb = e / 1536, r = e % 1536, rw = r / 768, c4 = r % 768;
        *(GAS f32x4*)(A.out + O_CONVS + ((size_t)bb * 3 + rw) * 3072 + 4 * c4) = *(const GAS f32x4*)(A.in[5] + ((size_t)bb * 3 + rw + 1) * 3072 + 4 * c4); }
}

__device__ __forceinline__ void mixer_phase_a(const Frame& F, const Args& A) {
    conv_prepass(F, A);
    attn_prompt_phase(F, A);
}
__device__ __forceinline__ void mixer_phase_b(const Frame& F, const Args& A) {
    for (int s = blockIdx.x; s < 256; s += F.G) ssd_stream(F, A, s);
    const int gw = blockIdx.x * NWAVES + F.wave, NGW = F.G * NWAVES;
    for (int it = gw; it < 128 * 24; it += NGW) attn_sample_item(F, A, it);
    for (int it = gw; it < 128 * 32; it += NGW) ssd_sample_item(F, A, it);
    emit_outputs(F, A);
}

__device__ __forceinline__ void combine_phase(const Frame& F, const Args& A) {
    unsigned char* ws = A.ws;
    const int gw = blockIdx.x * NWAVES + F.wave, NGW = F.G * NWAVES, lane = fresh_lane();
    const bf16* AOG = (const bf16*)(ws + WS_AOG); const float* LSE = (const float*)(ws + WS_LSE);
    const int h = lane >> 3;
    for (int m0 = gw; m0 < M_REAL; m0 += 4 * NGW) {
        float l0[4], l1[4], l2[4], sq[4]; v4u a[4], bq[4], c[4];
#pragma unroll
        for (int r = 0; r < 4; ++r) { const int mr = m0 + r * NGW; const size_t m = (size_t)(mr < M_REAL ? mr : m0);
            l0[r] = LSE[m * 8 + h]; l1[r] = LSE[LSE_STRIDE + m * 8 + h]; l2[r] = LSE[2 * LSE_STRIDE + m * 8 + h];
            a[r] = *(const GAS v4u*)(AOG + m * 512 + 8 * lane); bq[r] = *(const GAS v4u*)(AOG + AOG_STRIDE + m * 512 + 8 * lane); c[r] = *(const GAS v4u*)(AOG + 2 * AOG_STRIDE + m * 512 + 8 * lane);
            sq[r] = ((const float*)(ws + WS_SSQ))[m * 64 + lane]; }
#pragma unroll
        for (int r = 0; r < 4; ++r) { const int mr = m0 + r * NGW;
            const float mx = fmaxf(l0[r], fmaxf(l1[r], l2[r]));
            float w0 = ex2(l0[r] - mx), w1 = ex2(l1[r] - mx), w2 = ex2(l2[r] - mx);
            const float inv = 1.0f / (w0 + w1 + w2); w0 *= inv; w1 *= inv; w2 *= inv;
            v4u o;
            o.x = pg8::cvt_pk_bf16(w0 * bflo(a[r].x) + w1 * bflo(bq[r].x) + w2 * bflo(c[r].x), w0 * bfhi(a[r].x) + w1 * bfhi(bq[r].x) + w2 * bfhi(c[r].x));
            o.y = pg8::cvt_pk_bf16(w0 * bflo(a[r].y) + w1 * bflo(bq[r].y) + w2 * bflo(c[r].y), w0 * bfhi(a[r].y) + w1 * bfhi(bq[r].y) + w2 * bfhi(c[r].y));
            o.z = pg8::cvt_pk_bf16(w0 * bflo(a[r].z) + w1 * bflo(bq[r].z) + w2 * bflo(c[r].z), w0 * bfhi(a[r].z) + w1 * bfhi(bq[r].z) + w2 * bfhi(c[r].z));
            o.w = pg8::cvt_pk_bf16(w0 * bflo(a[r].w) + w1 * bflo(bq[r].w) + w2 * bflo(c[r].w), w0 * bfhi(a[r].w) + w1 * bfhi(bq[r].w) + w2 * bfhi(c[r].w));
            const float s = wave_sum(sq[r]);
            if (mr < M_REAL) { *(GAS v4u*)((bf16*)(ws + WS_AO) + (size_t)mr * 512 + 8 * lane) = o;
                if (lane == 0) ((float*)(ws + WS_RSTD))[mr] = 1.0f / sqrtf(s * (1.f / 2048.f) + EPS); }
        }
    }
}

__global__ void __launch_bounds__(NWAVES * 64, 2) fwd(Args args) {
    extern __shared__ __attribute__((aligned(16))) unsigned char lds[];
    Frame F;
    F.lds = (LAS unsigned char*)lds;
    F.MISC = (volatile LAS unsigned*)(F.lds + MISC_OFF);
    F.tid = threadIdx.x; F.lane = F.tid & 63; F.wave = __builtin_amdgcn_readfirstlane(F.tid >> 6);
    F.G = gridDim.x;
    unsigned char* ws = args.ws;
    F.ctl = (gu32*)(ws + WS_CTL);
    for (int u = F.tid; u < (LDS_BYTES - LDSCTL_OFF) / 4; u += NWAVES * 64) ((LAS unsigned*)(F.lds + LDSCTL_OFF))[u] = 0u;
    __syncthreads();
    if (F.tid < 32) ((LAS float*)(F.lds + LDSCTL_OFF))[F.tid] = INV_FREQ[F.tid];
    XcdBarrier bar = xcd_barrier_post((unsigned*)(F.ctl + CW_BAR), F.MISC + 8);
#define GRID_BAR() xcd_barrier(bar)
    const int bx = (int)blockIdx.x;
    int kple; asm volatile("s_mov_b32 %0, 256" : "=s"(kple));

    p0_prologue(F, args);
    GRID_BAR();
#define GEMM_REG(EPI, AOFF, BOFF, NN, KK, ...) do { pg8::Gemm g{(bf16*)(ws + (AOFF)), (bf16*)(ws + (BOFF)), P_ROWS, (NN), (KK), (KK)}; pg8::StaticOrder S; S.init(P_ROWS, (NN), F.G, bx); EPI E{__VA_ARGS__}; \
        pg8::gemm_phase<EPI, pg8::StaticOrder, true, true>(F.lds + RING_OFF, g, S, E); } while (0)
#define GEMM_REGV(EPI, AOFF, BOFF, NN, KK, ...) do { pg8::Gemm g{(bf16*)(ws + (AOFF)), (bf16*)(ws + (BOFF)), P_ROWS, (NN), (KK), (KK)}; pg8::StaticOrder S; S.init(P_ROWS, (NN), F.G, bx, 1); EPI E{__VA_ARGS__}; \
        pg8::gemm_phase<EPI, pg8::StaticOrder, true, true>(F.lds + RING_OFF, g, S, E); } while (0)
#define GEMM_SMP(EPI, AOFF, BOFF, NN, KK, PP_, ...) do { pg8::Gemm g{(bf16*)(ws + (AOFF)), (bf16*)(ws + (BOFF)), M_PAD, (NN), (KK) / (PP_), (KK)}; pg8::SampOrder S; S.init((NN), (PP_), (KK) / (PP_), F.G, bx); EPI E{__VA_ARGS__}; \
        pg8::gemm_phase<EPI, pg8::SampOrder, true, true, true>(F.lds + RING_OFF, g, S, E); } while (0)
    using EpiRB1 = pg8::EpiResBf<true, 1>; using EpiRB2 = pg8::EpiResBf<false, 2>; using EpiRB3 = pg8::EpiResBf<false, 1>;
    float* const HRp = (float*)(ws + WS_HR); float* const SQ2 = (float*)(ws + WS_SQ2);
#define SMP_NORM(SSQ_, CW_) do { sample_norm_phase(F, HRp, (bf16*)(ws + WS_U), (SSQ_)); if (bx < 16) { __threadfence(); __syncthreads(); \
        if (threadIdx.x == 0) __hip_atomic_fetch_add(F.ctl + (CW_), 1u, __ATOMIC_RELEASE, __HIP_MEMORY_SCOPE_AGENT); } } while (0)
#define SMP_WAIT(CW_, NU_) do { if (bx >= (NU_)) break; if (threadIdx.x == 0) { const unsigned need = F.G < 16 ? (unsigned)F.G : 16u; while (__hip_atomic_load(F.ctl + (CW_), __ATOMIC_ACQUIRE, __HIP_MEMORY_SCOPE_AGENT) < need) __builtin_amdgcn_s_sleep(4); } \
        __syncthreads(); } while (0)
    GEMM_REG(pg8::EpiSwiGLU<false>, WS_U, WS_W1A, 5632, 1024, (bf16*)(ws + WS_H1), DFF, nullptr);
    GEMM_SMP(pg8::EpiSwiGLU<false>, WS_U, WS_W1A, 5632, 1024, 1, (bf16*)(ws + WS_H1), DFF, nullptr);
#define PLE_SLICE(L0_, L1_, WG0_) do { if (bx >= (WG0_)) { pg8::Gemm g{(bf16*)(ws + WS_PB), (bf16*)(ws + WS_WPP), M_PAD, 1024, kple, kple}; pg8::RangeOrder S; S.init((L0_), (L1_), F.G - (WG0_), bx - (WG0_)); \
        pg8::EpiStoreBf16 E{(bf16*)(ws + WS_PP), 1024}; pg8::gemm_phase<pg8::EpiStoreBf16, pg8::RangeOrder, true, true>(F.lds + RING_OFF, g, S, E); } } while (0)
    if (F.G > 48) PLE_SLICE(0, 464, 24); else PLE_SLICE(0, 1028, 0);
    GRID_BAR();
    GEMM_REGV(EpiRB1, WS_H1, WS_W2A, 1024, DFF, args.in[0], (bf16*)(ws + WS_U), SQ2);
    GEMM_SMP(pg8::EpiResidAt, WS_H1, WS_W2A, 1024, DFF, 11, HRp, 0.5f);
    GRID_BAR();
    SMP_NORM(SQ2, CW_NRM);
    GEMM_REG(pg8::EpiWin, WS_U, WS_WIN, NV_IN, 1024, ws, args.in[17], SQ2, (LAS const float*)(F.lds + LDSCTL_OFF));
    SMP_WAIT(CW_NRM, 47);
    GEMM_SMP(pg8::EpiWin, WS_U, WS_WIN, NV_IN, 1024, 1, ws, args.in[17], SQ2, (LAS const float*)(F.lds + LDSCTL_OFF));
    if (F.G > 48) PLE_SLICE(464, 880, 48);
    GRID_BAR();
    mixer_phase_a(F, args);
    GRID_BAR();
    mixer_phase_b(F, args);
    GRID_BAR();
    combine_phase(F, args);
    GRID_BAR();
    GEMM_REGV(pg8::EpiOssm, WS_YG, WS_WOS, 1024, 2048, (bf16*)(ws + WS_T1), (bf16*)(ws + WS_GS), (const float*)(ws + WS_RSTD));
    GEMM_SMP(pg8::EpiOssmAt, WS_YG, WS_WOS, 1024, 2048, 8, (float*)(ws + WS_T1S), (bf16*)(ws + WS_GS), (const float*)(ws + WS_RSTD));
    GRID_BAR();
    GEMM_REG(pg8::EpiMerge<false>, WS_AO, WS_WOA, 1024, 512, (const bf16*)(ws + WS_T1), nullptr, (bf16*)(ws + WS_GA), (bf16*)(ws + WS_MG));
    GEMM_SMP(pg8::EpiMerge<true>, WS_AO, WS_WOA, 1024, 512, 1, nullptr, (const float*)(ws + WS_T1S), (bf16*)(ws + WS_GA), (bf16*)(ws + WS_MG));
    GRID_BAR();
    GEMM_REG(EpiRB2, WS_MG, WS_WOUT, 1024, 1024, nullptr, (bf16*)(ws + WS_U), SQ2 + M_PAD);
    GEMM_SMP(pg8::EpiResidAt, WS_MG, WS_WOUT, 1024, 1024, 4, HRp, 1.0f);
    GRID_BAR();
    SMP_NORM(SQ2 + M_PAD, CW_NRM + 1);
    GEMM_REG(pg8::EpiSwiGLU<true>, WS_U, WS_W1B, 5632, 1024, (bf16*)(ws + WS_H1), DFF, SQ2 + M_PAD);
    SMP_WAIT(CW_NRM + 1, 22);
    GEMM_SMP(pg8::EpiSwiGLU<true>, WS_U, WS_W1B, 5632, 1024, 1, (bf16*)(ws + WS_H1), DFF, SQ2 + M_PAD);
    if (F.G > 48) PLE_SLICE(880, 1028, 24);
    GRID_BAR();
    GEMM_REGV(EpiRB3, WS_H1, WS_W2B, 1024, DFF, nullptr, (bf16*)(ws + WS_U), SQ2 + 2 * M_PAD);
    GEMM_SMP(pg8::EpiResidAt, WS_H1, WS_W2B, 1024, DFF, 11, HRp, 0.5f);
    GRID_BAR();
    SMP_NORM(SQ2 + 2 * M_PAD, CW_NRM + 2);
    GEMM_REG(pg8::EpiPle, WS_U, WS_WPG, 1024, 1024, (bf16*)(ws + WS_U), (bf16*)(ws + WS_PP), SQ2 + 2 * M_PAD, (bf16*)(ws + WS_MG));
    SMP_WAIT(CW_NRM + 2, 4);
    GEMM_SMP(pg8::EpiPle, WS_U, WS_WPG, 1024, 1024, 1, (bf16*)(ws + WS_U), (bf16*)(ws + WS_PP), SQ2 + 2 * M_PAD, (bf16*)(ws + WS_MG));
    GRID_BAR();
    { const int gw = bx * NWAVES + F.wave, NGW = F.G * NWAVES;
      for (int m = gw; m < M_REAL; m += 4 * NGW) { const int left = (M_REAL - 1 - m) / NGW + 1;
          final_rows4((const bf16*)(ws + WS_MG), args.in[31], args.out, (size_t)m, (size_t)NGW, left < 4 ? left : 4, fresh_lane()); } }
}

extern "C" void kernel_launch(void* const* d_in, const int* in_sizes, int n_in, void* d_out, int out_size, void* d_ws, size_t ws_size, hipStream_t stream) {
    static int grid = 0;
    if (grid == 0) {
        if (n_in != 32 || ws_size < WS_END) { fprintf(stderr, "kernel_launch: need 32 inputs and >= %zu bytes of workspace; got n_in %d, ws %zu; nothing launched\n", (size_t)WS_END, n_in, ws_size); grid = -1; return; }
        int dev = 0, cus = 0, per_cu = 0;
        if (hipGetDevice(&dev) != hipSuccess || hipDeviceGetAttribute(&cus, hipDeviceAttributeMultiprocessorCount, dev) != hipSuccess) { grid = -1; return; }
        if (hipFuncSetAttribute((const void*)fwd, hipFuncAttributeMaxDynamicSharedMemorySize, LDS_BYTES) != hipSuccess) { fprintf(stderr, "kernel_launch: hipFuncSetAttribute failed\n"); grid = -1; return; }
        if (hipOccupancyMaxActiveBlocksPerMultiprocessor(&per_cu, (const void*)fwd, NWAVES * 64, LDS_BYTES) != hipSuccess || per_cu < 1)
            fprintf(stderr, "kernel_launch: note: occupancy query reports %d workgroups per CU\n", per_cu);
        (void)hipGetLastError();
        grid = cus;
    }
    if (grid < 0) return;
    if (hipMemsetAsync((char*)d_ws + WS_CTL, 0, CTL_ZERO_BYTES, stream) != hipSuccess) return;
    Args a{};
    for (int i = 0; i < 32; ++i) a.in[i] = (const float*)d_in[i];
    a.out = (float*)d_out; a.ws = (unsigned char*)d_ws;
    hipLaunchKernelGGL(fwd, dim3(grid), dim3(NWAVES * 64), LDS_BYTES, stream, a);
    const hipError_t le = hipPeekAtLastError();
    if (le != hipSuccess) fprintf(stderr, "kernel_launch: launch failed: %s\n", hipGetErrorName(le));
}
```
